# Optimizing an MI355X kernel written in HIP

```python
import jax, jax.numpy as jnp
from jax import lax
import numpy as np

D_MODEL = 1024
BATCH = 8
SEQ = 2048
DEPTH = 2
DEC_BATCH = 128
DEC_SEQ = 1
PAST_LEN = 16384
PAGE_SIZE = 128

D_A = D_MODEL
N_GROUPS_A = 4
CHUNK = 128
D_B = D_MODEL
CONV_W = 3
D_C = D_MODEL
POOL_WINDOWS = (2, 4, 8, 16)
N_GROUPS_C = len(POOL_WINDOWS)
G_C = D_C // N_GROUPS_C
POOL_BUF = max(POOL_WINDOWS) - 1
D_FF = 4 * D_MODEL
N_BRANCH = 3
ALPHA = float((2 * DEPTH) ** 0.25)
BETA = float((8 * DEPTH) ** -0.25)
LN_EPS = 1e-5
IN_SPLITS = (D_A, 2 * D_A, 2 * D_A + D_B, 2 * D_A + 2 * D_B, 2 * D_A + 3 * D_B, 2 * D_A + 3 * D_B + D_C)
D_IN = 2 * D_A + 3 * D_B + D_C + N_BRANCH * D_MODEL

kernel_name = "hybrid_gmlp_conv_pool_decoder_step"


def layer_norm(x, g, b):
    xf = x.astype(jnp.float32)
    mu = jnp.mean(xf, axis=-1, keepdims=True)
    var = jnp.mean(jnp.square(xf - mu), axis=-1, keepdims=True)
    y = (xf - mu) * lax.rsqrt(var + LN_EPS) * g.astype(jnp.float32) + b.astype(jnp.float32)
    return y.astype(x.dtype)


def chunk_mixer(u, v, lnv_g, lnv_b, w_s, b_s):
    bn, t, _ = u.shape
    vn = layer_norm(v, lnv_g, lnv_b)
    n_chunks = -(-t // CHUNK)
    pad = n_chunks * CHUNK - t
    vp = jnp.pad(vn, ((0, 0), (0, pad), (0, 0)))
    vc = vp.reshape(bn, n_chunks, CHUNK, N_GROUPS_A, D_A // N_GROUPS_A)
    mask = jnp.tril(jnp.ones((CHUNK, CHUNK), dtype=bool))
    ws = jnp.where(mask[None], w_s, 0.0).astype(v.dtype)
    s = jnp.einsum('gts,bnsgc->bntgc', ws, vc) + b_s.T[None, None, :, :, None]
    s = s.reshape(bn, n_chunks * CHUNK, D_A)[:, :t]
    return u * s, vn


def conv_mixer(bg, cg, xb, buf, conv_w, conv_b):
    t = xb.shape[1]
    z = cg * xb
    zp = jnp.concatenate([buf.astype(z.dtype), z], axis=1)
    y = conv_b + sum(conv_w[k] * zp[:, k:k + t] for k in range(CONV_W))
    return bg * y, zp[:, -(CONV_W - 1):]


def pool_mixer(p, buf, pos0, w_pool, pool_scale):
    bn, t, _ = p.shape
    pp = jnp.concatenate([buf.astype(p.dtype), p], axis=1)
    cs = jnp.pad(jnp.cumsum(pp.astype(jnp.float32), axis=1), ((0, 0), (1, 0), (0, 0)))
    hi = cs[:, POOL_BUF + 1:POOL_BUF + 1 + t]
    pos = pos0 + jnp.arange(t)
    means = []
    for g, w in enumerate(POOL_WINDOWS):
        sl = slice(g * G_C, (g + 1) * G_C)
        lo = cs[:, POOL_BUF + 1 - w:POOL_BUF + 1 - w + t, sl]
        cnt = jnp.minimum(pos + 1, w).astype(jnp.float32)[None, :, None]
        means.append((hi[..., sl] - lo) / cnt)
    mean = jnp.concatenate(means, axis=-1).astype(p.dtype)
    d = (mean - p).reshape(bn, t, N_GROUPS_C, G_C)
    y = jnp.einsum('btgc,gcd->btgd', d, w_pool).reshape(bn, t, D_C) * pool_scale
    return y, pp[:, -POOL_BUF:]


def trunk_layer(x, buf_conv, buf_pool, pos0, w_in, lnv_g, lnv_b, w_spatial, b_spatial, w_proj_a,
                conv_w, conv_b, w_proj_b, w_pool, pool_scale, w_proj_c, w_o,
                ln1_g, ln1_b, w_ff1, w_ff2, ln2_g, ln2_b):
    bn, t, _ = x.shape
    proj = x @ w_in
    u, v, bg, cg, xb, xc, gates = jnp.split(proj, IN_SPLITS, axis=-1)
    ha, vn = chunk_mixer(u, v, lnv_g, lnv_b, w_spatial, b_spatial)
    hb, new_conv = conv_mixer(bg, cg, xb, buf_conv, conv_w, conv_b)
    hc, new_pool = pool_mixer(xc, buf_pool, pos0, w_pool, pool_scale)
    gt = jax.nn.sigmoid(gates.astype(jnp.float32)).astype(x.dtype).reshape(bn, t, N_BRANCH, D_MODEL)
    merged = gt[:, :, 0] * (ha @ w_proj_a) + gt[:, :, 1] * (hb @ w_proj_b) + gt[:, :, 2] * (hc @ w_proj_c)
    h = layer_norm(ALPHA * x + merged @ w_o, ln1_g, ln1_b)
    f = jnp.square(jax.nn.relu(h @ w_ff1)) @ w_ff2
    out = layer_norm(ALPHA * h + f, ln2_g, ln2_b)
    return out, new_conv, new_pool, vn


def setup_inputs(seed: int = 0) -> dict:
    key = jax.random.key(seed)
    ks = jax.random.split(key, 24)
    f32 = jnp.float32
    nrm = lambda k, shape, s: (jax.random.normal(k, shape, f32) * s).astype(f32)
    return {
        'x_prompt': nrm(ks[0], (BATCH, SEQ, D_MODEL), 1.0),
        'x_sample': nrm(ks[1], (DEC_BATCH, DEC_SEQ, D_MODEL), 1.0),
        'state_conv': nrm(ks[2], (DEPTH, DEC_BATCH, CONV_W - 1, D_B), 1.0),
        'state_pool': nrm(ks[3], (DEPTH, DEC_BATCH, POOL_BUF, D_C), 1.0),
        'w_in': nrm(ks[4], (DEPTH, D_MODEL, D_IN), D_MODEL ** -0.5),
        'lnv_g': 1.0 + nrm(ks[5], (DEPTH, D_A), 0.02),
        'lnv_b': nrm(ks[6], (DEPTH, D_A), 0.02),
        'w_spatial': nrm(ks[7], (DEPTH, N_GROUPS_A, CHUNK, CHUNK), CHUNK ** -0.5),
        'b_spatial': 1.0 + nrm(ks[8], (DEPTH, N_GROUPS_A, CHUNK), 0.02),
        'w_proj_a': nrm(ks[9], (DEPTH, D_A, D_MODEL), BETA * D_A ** -0.5),
        'conv_w': nrm(ks[10], (DEPTH, CONV_W, D_B), CONV_W ** -0.5),
        'conv_b': nrm(ks[11], (DEPTH, D_B), 0.02),
        'w_proj_b': nrm(ks[12], (DEPTH, D_B, D_MODEL), BETA * D_B ** -0.5),
        'w_pool': nrm(ks[13], (DEPTH, N_GROUPS_C, G_C, G_C), G_C ** -0.5),
        'pool_scale': 0.5 + nrm(ks[14], (DEPTH, D_C), 0.1),
        'w_proj_c': nrm(ks[15], (DEPTH, D_C, D_MODEL), BETA * D_C ** -0.5),
        'w_o': nrm(ks[16], (DEPTH, D_MODEL, D_MODEL), BETA * D_MODEL ** -0.5),
        'ln1_g': 1.0 + nrm(ks[17], (DEPTH, D_MODEL), 0.02),
        'ln1_b': nrm(ks[18], (DEPTH, D_MODEL), 0.02),
        'w_ff1': nrm(ks[19], (DEPTH, D_MODEL, D_FF), D_MODEL ** -0.5),
        'w_ff2': nrm(ks[20], (DEPTH, D_FF, D_MODEL), BETA * D_FF ** -0.5),
        'ln2_g': 1.0 + nrm(ks[21], (DEPTH, D_MODEL), 0.02),
        'ln2_b': nrm(ks[22], (DEPTH, D_MODEL), 0.02),
    }


def reference(x_prompt, x_sample, state_conv, state_pool, w_in, lnv_g, lnv_b, w_spatial, b_spatial,
              w_proj_a, conv_w, conv_b, w_proj_b, w_pool, pool_scale, w_proj_c, w_o,
              ln1_g, ln1_b, w_ff1, w_ff2, ln2_g, ln2_b):
    bp = x_prompt.shape[0]
    xp = x_prompt
    xs = x_sample
    conv_p, pool_p, conv_s, pool_s, chunk_v_s = [], [], [], [], []
    for l in range(DEPTH):
        params = (w_in[l], lnv_g[l], lnv_b[l], w_spatial[l], b_spatial[l], w_proj_a[l],
                  conv_w[l], conv_b[l], w_proj_b[l], w_pool[l], pool_scale[l], w_proj_c[l], w_o[l],
                  ln1_g[l], ln1_b[l], w_ff1[l], w_ff2[l], ln2_g[l], ln2_b[l])
        zero_conv = jnp.zeros((bp, CONV_W - 1, D_B), xp.dtype)
        zero_pool = jnp.zeros((bp, POOL_BUF, D_C), xp.dtype)
        xp, nc_p, np_p, _ = trunk_layer(xp, zero_conv, zero_pool, 0, *params)
        xs, nc_s, np_s, vn_s = trunk_layer(xs, state_conv[l], state_pool[l], PAST_LEN, *params)
        conv_p.append(nc_p)
        pool_p.append(np_p)
        conv_s.append(nc_s)
        pool_s.append(np_s)
        chunk_v_s.append(vn_s)
    new_conv_prompt = jnp.stack(conv_p)
    new_pool_prompt = jnp.stack(pool_p)
    new_conv_sample = jnp.stack(conv_s)
    new_pool_sample = jnp.stack(pool_s)
    chunk_v_sample = jnp.stack(chunk_v_s)
    return (xp, xs, new_conv_prompt, new_pool_prompt, new_conv_sample, new_pool_sample, chunk_v_sample)
```

```cpp
#include <hip/hip_runtime.h>
#include <hip/hip_cooperative_groups.h>
#include <cstdio>
namespace cg = cooperative_groups;

#define LAS __attribute__((address_space(3)))
typedef unsigned short bf16_t;
typedef short bf16x8 __attribute__((ext_vector_type(8)));
typedef float f32x4 __attribute__((ext_vector_type(4)));

constexpr int D = 1024, TP = 16384, TS = 128, TV = TP + TS, T = 16640, NMT = T / 256;
constexpr int DIN = 9216, DFF = 4096, SEQ = 2048;
constexpr float ALPHA = 1.4142135623730951f;
constexpr float LN_EPS = 1e-5f;
constexpr int BM = 256, BK = 64, HALF = 128, HTB = HALF * BK * 2, STAGE_BYTES = 8 * HTB;

constexpr size_t SLOT = (size_t)T * D * 2;
constexpr size_t WS_WIN = 0;
constexpr size_t WS_WP = WS_WIN + (size_t)DIN * D * 2;
constexpr size_t WS_WO = WS_WP + 3ull * D * D * 2;
constexpr size_t WS_W1 = WS_WO + (size_t)D * D * 2;
constexpr size_t WS_W2 = WS_W1 + (size_t)DFF * D * 2;
constexpr size_t WS_WPOOL = WS_W2 + (size_t)DFF * D * 2;
constexpr size_t WS_WSBD = WS_WPOOL + 4ull * 256 * 256 * 2;
constexpr size_t WS_WSDG = WS_WSBD + 4ull * 256 * 256 * 2;
constexpr size_t WS_STATS = WS_WSDG + 4ull * 256 * 256 * 2;
constexpr size_t WS_SLOT0 = WS_STATS + (size_t)T * 8;
constexpr size_t WS_END = WS_SLOT0 + 7 * SLOT;

constexpr size_t O_Y = 0;
constexpr size_t O_CONVP = (size_t)TV * D;
constexpr size_t O_POOLP = O_CONVP + 2ull * 8 * 2 * D;
constexpr size_t O_CONVS = O_POOLP + 2ull * 8 * 15 * D;
constexpr size_t O_POOLS = O_CONVS + 2ull * 128 * 2 * D;
constexpr size_t O_CHV = O_POOLS + 2ull * 128 * 15 * D;

struct Params {
    const float *x_prompt, *x_sample, *state_conv, *state_pool, *w_in, *lnv_g, *lnv_b, *w_spatial, *b_spatial, *w_proj_a, *conv_w, *conv_b, *w_proj_b,
        *w_pool, *pool_scale, *w_proj_c, *w_o, *ln1_g, *ln1_b, *w_ff1, *w_ff2, *ln2_g, *ln2_b;
    float* out;
    unsigned char* ws;
    int ph0, ph1;
};

__device__ __forceinline__ unsigned short f2bf(float f) { unsigned u = __float_as_uint(f); u += 0x7FFFu + ((u >> 16) & 1u); return (unsigned short)(u >> 16); }
__device__ __forceinline__ unsigned cvt_pk_bf16(float lo, float hi) { unsigned r; asm volatile("v_cvt_pk_bf16_f32 %0, %1, %2" : "=v"(r) : "v"(lo), "v"(hi)); return r; }
__device__ __forceinline__ float bflo(unsigned u) { return __uint_as_float(u << 16); }
__device__ __forceinline__ float bfhi(unsigned u) { return __uint_as_float(u & 0xffff0000u); }
__device__ __forceinline__ uint4 pack8(const f32x4 a, const f32x4 b) { return make_uint4(cvt_pk_bf16(a[0], a[1]), cvt_pk_bf16(a[2], a[3]), cvt_pk_bf16(b[0], b[1]), cvt_pk_bf16(b[2], b[3])); }
__device__ __forceinline__ void unpack8(const uint4 u, f32x4& a, f32x4& b) { a[0] = bflo(u.x); a[1] = bfhi(u.x); a[2] = bflo(u.y); a[3] = bfhi(u.y); b[0] = bflo(u.z); b[1] = bfhi(u.z); b[2] = bflo(u.w); b[3] = bfhi(u.w); }
__device__ __forceinline__ float wave_sum(float v) {
#pragma unroll
    for (int m = 32; m >= 1; m >>= 1) v += __shfl_xor(v, m);
    return v;
}

__device__ __forceinline__ int lds_byte(int r, int c) { const int st = (r >> 4) * 2 + (c >> 5), rr = r & 15, cc = c & 31, ob = rr * 64 + cc * 2; return st * 1024 + (ob ^ (((ob >> 9) & 1) << 5)); }
__device__ __forceinline__ void stage_rc(int b, int& R, int& C) { const int st = b / 1024, sb = b % 1024, swz = sb ^ (((sb >> 9) & 1) << 5); R = (st >> 1) * 16 + swz / 64; C = (st & 1) * 32 + (swz % 64) / 2; }
__device__ __forceinline__ int perm32(int rho) { const int n = rho >> 4, i = rho & 15; return 8 * (i >> 2) + 4 * n + (i & 3); }

__device__ __forceinline__ const char* uni_ptr(const char* p) { unsigned long long v = (unsigned long long)p; unsigned lo = __builtin_amdgcn_readfirstlane((unsigned)v), hi = __builtin_amdgcn_readfirstlane((unsigned)(v >> 32)); asm volatile("" : "+s"(lo), "+s"(hi)); return (const char*)(((unsigned long long)hi << 32) | lo); }
__device__ __forceinline__ int opaque_tid() { int t = threadIdx.x; asm volatile("" : "+v"(t)); return t; }
struct Unit { const char* A; const char* B; unsigned ahs, bhs; int pm, pn, aux; };

__device__ __forceinline__ bool tile_order(int i, int nM, int nN, int& pm, int& pn) {
    int c = blockIdx.x; asm volatile("" : "+s"(c));
    const int G = gridDim.x, nwg = nM * nN;
    const long L = (long)i * G + c; if (L >= nwg) return false;
    int wgid = (int)L; { const int q = nwg / 8, r = nwg % 8, xcd = wgid % 8, off = wgid / 8; wgid = (xcd < r ? xcd * (q + 1) : r * (q + 1) + (xcd - r) * q) + off; }
    const int nig = 8 * nN, gid = wgid / nig, fm = gid * 8, gsz = (nM - fm) < 8 ? (nM - fm) : 8;
    pm = fm + ((wgid % nig) % gsz); pn = (wgid % nig) / gsz; return true;
}

template <class Sched, class Epi>
__device__ __forceinline__ void gemm_phase(LAS unsigned char* lds, const Sched& S, const Epi& E) {
    int tid = threadIdx.x; asm volatile("" : "+v"(tid));
    const int wid = __builtin_amdgcn_readfirstlane(tid >> 6), lane = tid & 63, wr = wid >> 2, wc = wid & 3, fr = lane & 15, fq = lane >> 4;
    constexpr int nt = Sched::NT;
    unsigned vA[2], vB[2];
#pragma unroll
    for (int i = 0; i < 2; ++i) { int R, C; stage_rc(tid * 16 + i * 8192, R, C); vA[i] = (unsigned)R * Sched::LDA2 + (unsigned)(C * 2); vB[i] = (unsigned)((R & ~31) + perm32(R & 31)) * Sched::LDB2 + (unsigned)(C * 2); }
    const size_t kstep = (size_t)(BK * 2);
    const unsigned ldsw = (unsigned)wid * 1024u;
    const int aoff = lds_byte(wr * 64 + fr, fq * 8), boff = lds_byte(wc * 32 + fr, fq * 8);
#define SA_(b, h) (((b) * 2 + (h)) * HTB)
#define SB_(b, h) ((4 + (b) * 2 + (h)) * HTB)
#define STAGE_(bufoff, gbase, voff) do { _Pragma("unroll") for (int _i = 0; _i < 2; ++_i) \
        __builtin_amdgcn_global_load_lds((const unsigned*)((const char*)(gbase) + (voff)[_i]), (LAS unsigned*)(lds + (bufoff) + ldsw + _i * 8192), 16, 0, 0); } while (0)
#define LDA_(dst, b, h) do { _Pragma("unroll") for (int m = 0; m < 4; ++m) _Pragma("unroll") for (int k = 0; k < 2; ++k) dst[m][k] = *(const LAS bf16x8*)(lds + SA_(b, h) + aoff + m * 2048 + k * 1024); } while (0)
#define LDB_(dst, b, h) do { _Pragma("unroll") for (int n = 0; n < 2; ++n) _Pragma("unroll") for (int k = 0; k < 2; ++k) dst[n][k] = *(const LAS bf16x8*)(lds + SB_(b, h) + boff + n * 2048 + k * 1024); } while (0)
#define MMA_(ai, bj, At, Bt) do { __builtin_amdgcn_s_setprio(1); _Pragma("unroll") for (int m = 0; m < 4; ++m) _Pragma("unroll") for (int n = 0; n < 2; ++n) _Pragma("unroll") for (int k = 0; k < 2; ++k) \
        acc[ai][bj][m][n] = __builtin_amdgcn_mfma_f32_16x16x32_bf16(Bt[n][k], At[m][k], acc[ai][bj][m][n], 0, 0, 0); __builtin_amdgcn_s_setprio(0); } while (0)
#define WAIT_V_(n) asm volatile("s_waitcnt vmcnt(" #n ")" ::: "memory")
#define WAIT_L_(n) asm volatile("s_waitcnt lgkmcnt(" #n ")" ::: "memory")
#define BAR_ __builtin_amdgcn_s_barrier()
#define SCHED_ __builtin_amdgcn_sched_barrier(0)
    Unit cur, nxt; int ui = 0;
    if (!S.next(0, cur)) return;
    cur.A = uni_ptr(cur.A); cur.B = uni_ptr(cur.B);
    f32x4 acc[2][2][4][2];
#pragma unroll
    for (int a = 0; a < 2; ++a)
#pragma unroll
        for (int b = 0; b < 2; ++b)
#pragma unroll
            for (int m = 0; m < 4; ++m)
#pragma unroll
                for (int n = 0; n < 2; ++n) acc[a][b][m][n] = (f32x4){0.f, 0.f, 0.f, 0.f};
    bf16x8 At[4][2], B0[2][2], B1[2][2];
    const char* cA = cur.A; const char* cB = cur.B;
    STAGE_(SB_(0, 0), cB, vB); STAGE_(SA_(0, 0), cA, vA); STAGE_(SB_(0, 1), cB + cur.bhs, vB); STAGE_(SA_(0, 1), cA + cur.ahs, vA);
    if (wr == 1) BAR_;
    WAIT_V_(4); BAR_;
    STAGE_(SB_(1, 0), cB + kstep, vB); STAGE_(SA_(1, 0), cA + kstep, vA); STAGE_(SB_(1, 1), cB + cur.bhs + kstep, vB);
    WAIT_V_(6); BAR_;
    for (;;) {
        const bool has_next = S.next(ui + 1, nxt);
        if (!has_next) nxt = cur;
        nxt.A = uni_ptr(nxt.A); nxt.B = uni_ptr(nxt.B);
        const char* nA = nxt.A; const char* nB = nxt.B;
#pragma unroll 1
        for (int t = 0; t < nt; t += 2) {
            const bool last = (t == nt - 2);
            const char* a1 = cA + (size_t)(t + 1) * kstep;
            const char* a2 = last ? nA : cA + (size_t)(t + 2) * kstep; const char* b2 = last ? nB : cB + (size_t)(t + 2) * kstep;
            const char* a3 = a2 + kstep; const char* b3 = b2 + kstep;
            const unsigned ahs2 = last ? nxt.ahs : cur.ahs, bhs2 = last ? nxt.bhs : cur.bhs;
            LDB_(B0, 0, 0); SCHED_; LDA_(At, 0, 0); STAGE_(SA_(1, 1), a1 + cur.ahs, vA);
            WAIT_L_(8); BAR_; WAIT_L_(0); MMA_(0, 0, At, B0); BAR_; SCHED_;
            LDB_(B1, 0, 1); STAGE_(SB_(0, 0), b2, vB);
            BAR_; WAIT_L_(0); MMA_(0, 1, At, B1); BAR_;
            LDA_(At, 0, 1); STAGE_(SA_(0, 0), a2, vA);
            BAR_; WAIT_L_(0); MMA_(1, 0, At, B0); BAR_; SCHED_;
            STAGE_(SB_(0, 1), b2 + bhs2, vB);
            WAIT_V_(6); BAR_; MMA_(1, 1, At, B1); BAR_;
            LDB_(B0, 1, 0); SCHED_; LDA_(At, 1, 0); STAGE_(SA_(0, 1), a2 + ahs2, vA);
            WAIT_L_(8); BAR_; WAIT_L_(0); MMA_(0, 0, At, B0); BAR_; SCHED_;
            LDB_(B1, 1, 1); STAGE_(SB_(1, 0), b3, vB);
            BAR_; WAIT_L_(0); MMA_(0, 1, At, B1); BAR_;
            LDA_(At, 1, 1); STAGE_(SA_(1, 0), a3, vA);
            BAR_; WAIT_L_(0); MMA_(1, 0, At, B0); BAR_; SCHED_;
            STAGE_(SB_(1, 1), b3 + bhs2, vB);
            WAIT_V_(6); BAR_; MMA_(1, 1, At, B1); BAR_;
        }
        int fr2 = fr, fq2 = fq; asm volatile("" : "+v"(fr2), "+v"(fq2));
        const bool fin = E.finish(acc, cur, wr, wc, fr2, fq2);
        if (!has_next) break;
        if (fin) {
#pragma unroll
            for (int a = 0; a < 2; ++a)
#pragma unroll
                for (int b = 0; b < 2; ++b)
#pragma unroll
                    for (int m = 0; m < 4; ++m)
#pragma unroll
                        for (int n = 0; n < 2; ++n) acc[a][b][m][n] = (f32x4){0.f, 0.f, 0.f, 0.f};
        }
        cur = nxt; cA = nA; cB = nB; ++ui;
    }
    WAIT_V_(0);
    if (wr == 0) BAR_;
    BAR_;
#undef SA_
#undef SB_
#undef STAGE_
#undef LDA_
#undef LDB_
#undef MMA_
#undef WAIT_V_
#undef WAIT_L_
#undef BAR_
#undef SCHED_
}

#define ACC_T f32x4 (&acc)[2][2][4][2]
#define ROW_(u, ai, m) ((u).pm * 256 + (ai) * 128 + wr * 64 + (m) * 16 + fr)

struct SchedG1 {
    static constexpr int NT = 16; static constexpr unsigned LDA2 = 2048, LDB2 = 2048; const char *xb, *win;
    __device__ __forceinline__ bool next(int i, Unit& u) const {
        int pm, pn; if (!tile_order(i, NMT, 24, pm, pn)) return false;
        u.pm = pm; u.pn = pn; u.aux = 0; u.A = xb + (size_t)pm * 256 * 2048; u.ahs = 128 * 2048;
        if (pn < 12) { u.B = win + (size_t)pn * 256 * 2048; u.bhs = 128 * 2048; }
        else if (pn < 20) { u.B = win + (size_t)(3072 + 128 * (pn - 12)) * 2048; u.bhs = 1024 * 2048; }
        else { u.B = win + (size_t)(5120 + 256 * (pn - 20)) * 2048; u.bhs = 128 * 2048; }
        return true;
    }
};
struct EpiG1 {
    unsigned char* slots;
    __device__ __forceinline__ bool finish(ACC_T, const Unit& u, int wr, int wc, int fr, int fq) const {
        const int ct = u.pn;
        if (ct >= 12 && ct < 20) {
            bf16_t* o = (bf16_t*)(slots + 4 * SLOT) + 128 * (ct - 12) + wc * 32 + 8 * fq;
#pragma unroll
            for (int ai = 0; ai < 2; ++ai)
#pragma unroll
                for (int m = 0; m < 4; ++m) { const size_t row = ROW_(u, ai, m);
                    *(uint4*)(o + row * D) = pack8(acc[ai][0][m][0] * acc[ai][1][m][0], acc[ai][0][m][1] * acc[ai][1][m][1]); }
        } else {
            const int sl = ct < 12 ? 1 + (ct >> 2) : 5, ctile = ct < 12 ? (ct & 3) : ct - 20;
            bf16_t* o = (bf16_t*)(slots + (size_t)sl * SLOT) + ctile * 256 + wc * 32 + 8 * fq;
#pragma unroll
            for (int ai = 0; ai < 2; ++ai)
#pragma unroll
                for (int m = 0; m < 4; ++m) { const size_t row = ROW_(u, ai, m);
#pragma unroll
                    for (int bj = 0; bj < 2; ++bj) *(uint4*)(o + row * D + bj * 128) = pack8(acc[ai][bj][m][0], acc[ai][bj][m][1]); }
        }
        return true;
    }
};

struct SchedSpat {
    static constexpr int NT = 4; static constexpr unsigned LDA2 = 512, LDB2 = T * 2; const char *wsbd, *wsdg, *vnT;
    __device__ __forceinline__ bool next(int i, Unit& u) const {
        int c = blockIdx.x; asm volatile("" : "+s"(c)); const long L = (long)i * gridDim.x + c; if (L >= NMT * 4) return false;
        const int pm = (int)L >> 2, g = (int)L & 3; u.pm = pm; u.pn = g; u.aux = 0;
        u.A = (pm < TP / 256 ? wsbd : wsdg) + (size_t)g * 256 * 512; u.ahs = 128 * 512;
        u.B = vnT + ((size_t)g * 256 * T + (size_t)pm * 256) * 2; u.bhs = 128u * T * 2; return true;
    }
};
struct SchedPool {
    static constexpr int NT = 4; static constexpr unsigned LDA2 = 2048, LDB2 = 512; const char *dbuf, *wpoolT;
    __device__ __forceinline__ bool next(int i, Unit& u) const {
        int c = blockIdx.x; asm volatile("" : "+s"(c)); const long L = (long)i * gridDim.x + c; if (L >= NMT * 4) return false;
        const int pm = (int)L >> 2, g = (int)L & 3; u.pm = pm; u.pn = g; u.aux = 1;
        u.A = dbuf + ((size_t)pm * 256 * D + g * 256) * 2; u.ahs = 128 * 2048;
        u.B = wpoolT + (size_t)g * 256 * 512; u.bhs = 128 * 512; return true;
    }
};
struct EpiSpat {
    unsigned char* slots; const float* bsp;
    __device__ __forceinline__ bool finish(ACC_T, const Unit& u, int wr, int wc, int fr, int fq) const {
        const int g = u.pn;
        bf16_t* o = (bf16_t*)(slots + 1 * SLOT) + g * 256 + wc * 32 + 8 * fq;
#pragma unroll
        for (int ai = 0; ai < 2; ++ai)
#pragma unroll
            for (int m = 0; m < 4; ++m) { const int row = ROW_(u, ai, m); const float bs = bsp[g * 128 + (row < TP ? (row & 127) : 0)];
#pragma unroll
                for (int bj = 0; bj < 2; ++bj) { bf16_t* q = o + (size_t)row * D + bj * 128; f32x4 u0, u1; unpack8(*(const uint4*)q, u0, u1);
                    *(uint4*)q = pack8(u0 * (acc[ai][bj][m][0] + bs), u1 * (acc[ai][bj][m][1] + bs)); }
                if (m & 1) { asm volatile("" ::: "memory"); __builtin_amdgcn_sched_barrier(0); } }
        return true;
    }
};
struct EpiPool {
    unsigned char* slots; const float* pscale;
    __device__ __forceinline__ bool finish(ACC_T, const Unit& u, int wr, int wc, int fr, int fq) const {
        const int g = u.pn;
        bf16_t* o = (bf16_t*)(slots + 2 * SLOT) + g * 256 + wc * 32 + 8 * fq;
        f32x4 sc[2][2];
#pragma unroll
        for (int bj = 0; bj < 2; ++bj)
#pragma unroll
            for (int n = 0; n < 2; ++n) sc[bj][n] = *(const f32x4*)(pscale + g * 256 + bj * 128 + wc * 32 + 8 * fq + 4 * n);
#pragma unroll
        for (int ai = 0; ai < 2; ++ai)
#pragma unroll
            for (int m = 0; m < 4; ++m) { const size_t row = ROW_(u, ai, m);
#pragma unroll
                for (int bj = 0; bj < 2; ++bj) *(uint4*)(o + row * D + bj * 128) = pack8(acc[ai][bj][m][0] * sc[bj][0], acc[ai][bj][m][1] * sc[bj][1]); }
        return true;
    }
};

struct SchedGG {
    static constexpr int NT = 16; static constexpr unsigned LDA2 = 2048, LDB2 = 2048; const char *xb, *win;
    __device__ __forceinline__ bool next(int i, Unit& u) const {
        int pm, pn; if (!tile_order(i, NMT, 12, pm, pn)) return false;
        u.pm = pm; u.pn = pn; u.aux = 0; u.A = xb + (size_t)pm * 256 * 2048; u.ahs = 128 * 2048;
        u.B = win + (size_t)(6144 + 256 * pn) * 2048; u.bhs = 128 * 2048; return true;
    }
};
struct EpiGG {
    unsigned char* slots;
    __device__ __forceinline__ bool finish(ACC_T, const Unit& u, int wr, int wc, int fr, int fq) const {
        bf16_t* o = (bf16_t*)(slots + (size_t)(4 + (u.pn >> 2)) * SLOT) + (u.pn & 3) * 256 + wc * 32 + 8 * fq;
#pragma unroll
        for (int ai = 0; ai < 2; ++ai)
#pragma unroll
            for (int m = 0; m < 4; ++m) { const size_t row = ROW_(u, ai, m);
#pragma unroll
                for (int bj = 0; bj < 2; ++bj) { f32x4 s0, s1;
#pragma unroll
                    for (int k = 0; k < 4; ++k) { s0[k] = 1.f / (1.f + __expf(-acc[ai][bj][m][0][k])); s1[k] = 1.f / (1.f + __expf(-acc[ai][bj][m][1][k])); }
                    *(uint4*)(o + row * D + bj * 128) = pack8(s0, s1); } }
        return true;
    }
};

struct SchedP3 {
    static constexpr int NT = 16; static constexpr unsigned LDA2 = 2048, LDB2 = 2048; const char *slots, *wp;
    __device__ __forceinline__ bool next(int i, Unit& u) const {
        const int un = i / 3, seg = i - un * 3; int pm, pn; if (!tile_order(un, NMT, 4, pm, pn)) return false;
        u.pm = pm; u.pn = pn; u.aux = seg; const int sl = seg == 0 ? 1 : (seg == 1 ? 3 : 2);
        u.A = slots + (size_t)sl * SLOT + (size_t)pm * 256 * 2048; u.ahs = 128 * 2048;
        u.B = wp + ((size_t)seg * 1024 + pn * 256) * 2048; u.bhs = 128 * 2048; return true;
    }
};
struct EpiP3 {
    unsigned char* slots;
    __device__ __forceinline__ bool finish(ACC_T, const Unit& u, int wr, int wc, int fr, int fq) const {
        const int seg = u.aux; const size_t cofs = (size_t)u.pn * 256 + wc * 32 + 8 * fq;
        const bf16_t* ga = (const bf16_t*)(slots + (size_t)(4 + seg) * SLOT) + cofs;
        bf16_t* o = (bf16_t*)(slots) + cofs;
#pragma unroll
        for (int ai = 0; ai < 2; ++ai)
#pragma unroll
            for (int m = 0; m < 4; ++m) { const size_t row = ROW_(u, ai, m);
#pragma unroll
                for (int bj = 0; bj < 2; ++bj) { f32x4 a0, a1; unpack8(*(const uint4*)(ga + row * D + bj * 128), a0, a1);
                    f32x4 v0 = acc[ai][bj][m][0] * a0, v1 = acc[ai][bj][m][1] * a1;
                    if (seg > 0) { f32x4 p0, p1; unpack8(*(const uint4*)(o + row * D + bj * 128), p0, p1); v0 += p0; v1 += p1; }
                    *(uint4*)(o + row * D + bj * 128) = pack8(v0, v1); }
                if (m & 1) { asm volatile("" ::: "memory"); __builtin_amdgcn_sched_barrier(0); } }
        return true;
    }
};

struct SchedN4 {
    static constexpr int NT = 16; static constexpr unsigned LDA2 = 2048, LDB2 = 2048; const char *A, *B;
    __device__ __forceinline__ bool next(int i, Unit& u) const {
        int pm, pn; if (!tile_order(i, NMT, 4, pm, pn)) return false;
        u.pm = pm; u.pn = pn; u.aux = 0; u.A = A + (size_t)pm * 256 * 2048; u.ahs = 128 * 2048; u.B = B + (size_t)pn * 256 * 2048; u.bhs = 128 * 2048; return true;
    }
};
struct EpiWO {
    float* y1; const float *xa, *xb_;
    __device__ __forceinline__ bool finish(ACC_T, const Unit& u, int wr, int wc, int fr, int fq) const {
        const int c0 = u.pn * 256 + wc * 32 + 8 * fq;
#pragma unroll
        for (int ai = 0; ai < 2; ++ai)
#pragma unroll
            for (int m = 0; m < 4; ++m) { const int row = ROW_(u, ai, m); const float* xr = row < TP ? xa + (size_t)row * D : xb_ + (size_t)(row - TP) * D; const bool ok = row < TV;
#pragma unroll
                for (int bj = 0; bj < 2; ++bj)
#pragma unroll
                    for (int n = 0; n < 2; ++n) { const int c = c0 + bj * 128 + 4 * n; f32x4 xv = (f32x4){0.f, 0.f, 0.f, 0.f}; if (ok) xv = *(const f32x4*)(xr + c);
                        *(f32x4*)(y1 + (size_t)row * D + c) = xv * ALPHA + acc[ai][bj][m][n]; }
                if (m & 1) { asm volatile("" ::: "memory"); __builtin_amdgcn_sched_barrier(0); } }
        return true;
    }
};

struct SchedFF1 {
    static constexpr int NT = 16; static constexpr unsigned LDA2 = 2048, LDB2 = 2048; const char *A, *B;
    __device__ __forceinline__ bool next(int i, Unit& u) const {
        int pm, pn; if (!tile_order(i, NMT, 16, pm, pn)) return false;
        u.pm = pm; u.pn = pn; u.aux = 0; u.A = A + (size_t)pm * 256 * 2048; u.ahs = 128 * 2048; u.B = B + (size_t)pn * 256 * 2048; u.bhs = 128 * 2048; return true;
    }
};
struct EpiFF1 {
    bf16_t* f1;
    __device__ __forceinline__ bool finish(ACC_T, const Unit& u, int wr, int wc, int fr, int fq) const {
        bf16_t* o = f1 + u.pn * 256 + wc * 32 + 8 * fq;
#pragma unroll
        for (int ai = 0; ai < 2; ++ai)
#pragma unroll
            for (int m = 0; m < 4; ++m) { const size_t row = ROW_(u, ai, m);
#pragma unroll
                for (int bj = 0; bj < 2; ++bj) { f32x4 s0, s1;
#pragma unroll
                    for (int k = 0; k < 4; ++k) { const float a = fmaxf(acc[ai][bj][m][0][k], 0.f), b = fmaxf(acc[ai][bj][m][1][k], 0.f); s0[k] = a * a; s1[k] = b * b; }
                    *(uint4*)(o + row * DFF + bj * 128) = pack8(s0, s1); } }
        return true;
    }
};

struct SchedFF2 {
    static constexpr int NT = 64; static constexpr unsigned LDA2 = 8192, LDB2 = 8192; const char *A, *B;
    __device__ __forceinline__ bool next(int i, Unit& u) const {
        int pm, pn; if (!tile_order(i, NMT, 4, pm, pn)) return false;
        u.pm = pm; u.pn = pn; u.aux = 0; u.A = A + (size_t)pm * 256 * 8192; u.ahs = 128 * 8192; u.B = B + (size_t)pn * 256 * 8192; u.bhs = 128 * 8192; return true;
    }
};
struct EpiFF2 {
    float* y1; const float* stats; const float *g, *b;
    __device__ __forceinline__ bool finish(ACC_T, const Unit& u, int wr, int wc, int fr, int fq) const {
        const int c0 = u.pn * 256 + wc * 32 + 8 * fq;
        f32x4 gv[2][2], bv[2][2];
#pragma unroll
        for (int bj = 0; bj < 2; ++bj)
#pragma unroll
            for (int n = 0; n < 2; ++n) { gv[bj][n] = *(const f32x4*)(g + c0 + bj * 128 + 4 * n); bv[bj][n] = *(const f32x4*)(b + c0 + bj * 128 + 4 * n); }
#pragma unroll
        for (int ai = 0; ai < 2; ++ai)
#pragma unroll
            for (int m = 0; m < 4; ++m) { const int row = ROW_(u, ai, m); const float mu = stats[2 * row], rs = stats[2 * row + 1];
#pragma unroll
                for (int bj = 0; bj < 2; ++bj)
#pragma unroll
                    for (int n = 0; n < 2; ++n) { float* q = y1 + (size_t)row * D + c0 + bj * 128 + 4 * n; const f32x4 y = *(const f32x4*)q;
                        const f32x4 h = (y - mu) * rs * gv[bj][n] + bv[bj][n]; *(f32x4*)q = h * ALPHA + acc[ai][bj][m][n]; }
                if (m & 1) { asm volatile("" ::: "memory"); __builtin_amdgcn_sched_barrier(0); } }
        return true;
    }
};

__device__ __forceinline__ void conv_tile(const float* src, int N, bf16_t* dst, int K, int k0, int n0, LAS unsigned short* tile) {
    const int tid = opaque_tid();
#pragma unroll
    for (int i = 0; i < 2; ++i) { const int k = (tid >> 4) + 32 * i, n4 = (tid & 15) * 4; const float4 v = *(const float4*)(src + (size_t)(k0 + k) * N + n0 + n4);
        tile[(n4 + 0) * 66 + k] = f2bf(v.x); tile[(n4 + 1) * 66 + k] = f2bf(v.y); tile[(n4 + 2) * 66 + k] = f2bf(v.z); tile[(n4 + 3) * 66 + k] = f2bf(v.w); }
    __syncthreads();
    { const int n = tid >> 3, k8 = (tid & 7) * 8; const LAS unsigned* s = (const LAS unsigned*)(tile + n * 66 + k8);
        *(uint4*)(dst + (size_t)(n0 + n) * K + k0 + k8) = make_uint4(s[0], s[1], s[2], s[3]); }
    __syncthreads();
}

__device__ __forceinline__ void phase_convert(const Params& p, long z, int l, LAS unsigned char* lds) {
    unsigned char* ws = (p.ws + z); LAS unsigned short* tile = (LAS unsigned short*)lds;
    for (int t = blockIdx.x; t < 5440; t += gridDim.x) {
        const float* src; bf16_t* dst; int K, N, tt;
        if (t < 2304) { tt = t; src = (p.w_in + z) + (size_t)l * D * DIN; K = D; N = DIN; dst = (bf16_t*)(ws + WS_WIN); }
        else if (t < 3072) { const int i = (t - 2304) >> 8; tt = (t - 2304) & 255; src = (i == 0 ? (p.w_proj_a + z) : (i == 1 ? (p.w_proj_b + z) : (p.w_proj_c + z))) + (size_t)l * D * D; K = D; N = D; dst = (bf16_t*)(ws + WS_WP) + (size_t)i * D * D; }
        else if (t < 3328) { tt = t - 3072; src = (p.w_o + z) + (size_t)l * D * D; K = D; N = D; dst = (bf16_t*)(ws + WS_WO); }
        else if (t < 4352) { tt = t - 3328; src = (p.w_ff1 + z) + (size_t)l * D * DFF; K = D; N = DFF; dst = (bf16_t*)(ws + WS_W1); }
        else if (t < 5376) { tt = t - 4352; src = (p.w_ff2 + z) + (size_t)l * D * DFF; K = DFF; N = D; dst = (bf16_t*)(ws + WS_W2); }
        else { const int g = (t - 5376) >> 4; tt = (t - 5376) & 15; src = (p.w_pool + z) + ((size_t)l * 4 + g) * 65536; K = 256; N = 256; dst = (bf16_t*)(ws + WS_WPOOL) + (size_t)g * 65536; }
        const int nkt = K / 64, kt = tt % nkt, ntile = tt / nkt;
        conv_tile(src, N, dst, K, kt * 64, ntile * 64, tile);
    }
    const float* wsp = (p.w_spatial + z) + (size_t)l * 4 * 128 * 128;
    bf16_t* bd = (bf16_t*)(ws + WS_WSBD); bf16_t* dg = (bf16_t*)(ws + WS_WSDG);
    for (int i = blockIdx.x * 512 + opaque_tid(); i < 4 * 65536; i += gridDim.x * 512) {
        const int g = i >> 16, r = (i >> 8) & 255, c = i & 255;
        const bool on = ((r >> 7) == (c >> 7)) && ((c & 127) <= (r & 127));
        bd[i] = on ? f2bf(wsp[g * 16384 + (r & 127) * 128 + (c & 127)]) : (bf16_t)0;
        dg[i] = (r == c) ? f2bf(wsp[g * 16384]) : (bf16_t)0;
    }
}

__device__ __forceinline__ void phase_xb(const Params& p, long z) {
    bf16_t* xb = (bf16_t*)((p.ws + z) + WS_SLOT0);
    for (int i = blockIdx.x * 512 + opaque_tid(); i < T * 128; i += gridDim.x * 512) {
        const int row = i >> 7, c8 = (i & 127) * 8; uint4 o = make_uint4(0, 0, 0, 0);
        if (row < TV) { const float* s = (row < TP ? (p.x_prompt + z) + (size_t)row * D : (p.x_sample + z) + (size_t)(row - TP) * D) + c8; const float4 a = *(const float4*)s, b = *(const float4*)(s + 4);
            o = make_uint4(cvt_pk_bf16(a.x, a.y), cvt_pk_bf16(a.z, a.w), cvt_pk_bf16(b.x, b.y), cvt_pk_bf16(b.z, b.w)); }
        *(uint4*)(xb + (size_t)row * D + c8) = o;
    }
}

__device__ __forceinline__ void phase_e1(const Params& p, long z, int l, LAS unsigned char* lds) {
    unsigned char* sl = (p.ws + z) + WS_SLOT0; const int tid = opaque_tid(), wid = tid >> 6, lane = tid & 63;
    const bf16_t* V = (const bf16_t*)(sl + 2 * SLOT); bf16_t* vnT = (bf16_t*)(sl + 6 * SLOT);
    LAS unsigned short* tile = (LAS unsigned short*)lds;
    const float* lg = (p.lnv_g + z) + l * D + lane * 16; const float* lb = (p.lnv_b + z) + l * D + lane * 16;
    for (int task = blockIdx.x; task < T / 32; task += gridDim.x) {
        const int r0 = task * 32;
#pragma unroll 1
        for (int rr = 0; rr < 4; ++rr) {
            const int lr = wid * 4 + rr, row = r0 + lr;
            const uint4 a = *(const uint4*)(V + (size_t)row * D + lane * 16), b = *(const uint4*)(V + (size_t)row * D + lane * 16 + 8);
            f32x4 x0, x1, x2, x3; unpack8(a, x0, x1); unpack8(b, x2, x3);
            float s = 0.f;
#pragma unroll
            for (int k = 0; k < 4; ++k) s += x0[k] + x1[k] + x2[k] + x3[k];
            const float mu = wave_sum(s) * (1.f / D);
            x0 -= mu; x1 -= mu; x2 -= mu; x3 -= mu;
            float q = 0.f;
#pragma unroll
            for (int k = 0; k < 4; ++k) q += x0[k] * x0[k] + x1[k] * x1[k] + x2[k] * x2[k] + x3[k] * x3[k];
            const float rs = rsqrtf(wave_sum(q) * (1.f / D) + LN_EPS);
            x0 = x0 * rs * *(const f32x4*)(lg) + *(const f32x4*)(lb); x1 = x1 * rs * *(const f32x4*)(lg + 4) + *(const f32x4*)(lb + 4);
            x2 = x2 * rs * *(const f32x4*)(lg + 8) + *(const f32x4*)(lb + 8); x3 = x3 * rs * *(const f32x4*)(lg + 12) + *(const f32x4*)(lb + 12);
            LAS unsigned* tw = (LAS unsigned*)(tile + lr * 1026 + lane * 16);
            const uint4 o0 = pack8(x0, x1), o1 = pack8(x2, x3);
            tw[0] = o0.x; tw[1] = o0.y; tw[2] = o0.z; tw[3] = o0.w; tw[4] = o1.x; tw[5] = o1.y; tw[6] = o1.z; tw[7] = o1.w;
            if (row >= TP && row < TV) { float* cv = (p.out + z) + O_CHV + ((size_t)l * TS + (row - TP)) * D + lane * 16;
                *(f32x4*)cv = x0; *(f32x4*)(cv + 4) = x1; *(f32x4*)(cv + 8) = x2; *(f32x4*)(cv + 12) = x3; }
        }
        __syncthreads();
#pragma unroll 1
        for (int j = 0; j < 2; ++j) {
            const int c = tid + 512 * j; unsigned w[16];
#pragma unroll
            for (int t2 = 0; t2 < 16; ++t2) w[t2] = (unsigned)tile[(2 * t2) * 1026 + c] | ((unsigned)tile[(2 * t2 + 1) * 1026 + c] << 16);
            uint4* o = (uint4*)(vnT + (size_t)c * T + r0);
            o[0] = make_uint4(w[0], w[1], w[2], w[3]); o[1] = make_uint4(w[4], w[5], w[6], w[7]); o[2] = make_uint4(w[8], w[9], w[10], w[11]); o[3] = make_uint4(w[12], w[13], w[14], w[15]);
        }
        __syncthreads();
    }
    bf16_t* Bg = (bf16_t*)(sl + 3 * SLOT); const bf16_t* Z = (const bf16_t*)(sl + 4 * SLOT);
    const float* cw = (p.conv_w + z) + (size_t)l * 3 * D; const float* cb = (p.conv_b + z) + (size_t)l * D; const float* sc = (p.state_conv + z) + (size_t)l * TS * 2 * D;
    for (int i = blockIdx.x * 512 + tid; i < T * 128; i += gridDim.x * 512) {
        const int row = i >> 7, c8 = (i & 127) * 8;
        f32x4 b0, b1, z00, z01, z10, z11, z20, z21;
        const f32x4 zero = (f32x4){0.f, 0.f, 0.f, 0.f};
        unpack8(*(const uint4*)(Bg + (size_t)row * D + c8), b0, b1);
        unpack8(*(const uint4*)(Z + (size_t)row * D + c8), z00, z01);
        z10 = z11 = z20 = z21 = zero;
        if (row < TP) { const int pos = row & (SEQ - 1);
            if (pos >= 1) unpack8(*(const uint4*)(Z + (size_t)(row - 1) * D + c8), z10, z11);
            if (pos >= 2) unpack8(*(const uint4*)(Z + (size_t)(row - 2) * D + c8), z20, z21);
            if (pos >= SEQ - 2) { float* o = (p.out + z) + O_CONVP + (((size_t)l * 8 + (row >> 11)) * 2 + (pos - (SEQ - 2))) * D + c8; *(f32x4*)o = z00; *(f32x4*)(o + 4) = z01; }
        } else if (row < TV) { const int bi = row - TP; const float* s0 = sc + (size_t)bi * 2 * D + c8;
            z20 = *(const f32x4*)s0; z21 = *(const f32x4*)(s0 + 4); z10 = *(const f32x4*)(s0 + D); z11 = *(const f32x4*)(s0 + D + 4);
            float* o = (p.out + z) + O_CONVS + ((size_t)l * TS + bi) * 2 * D + c8; *(f32x4*)o = z10; *(f32x4*)(o + 4) = z11; *(f32x4*)(o + D) = z00; *(f32x4*)(o + D + 4) = z01; }
        const f32x4 y0 = *(const f32x4*)(cb + c8) + *(const f32x4*)(cw + c8) * z20 + *(const f32x4*)(cw + D + c8) * z10 + *(const f32x4*)(cw + 2 * D + c8) * z00;
        const f32x4 y1 = *(const f32x4*)(cb + c8 + 4) + *(const f32x4*)(cw + c8 + 4) * z21 + *(const f32x4*)(cw + D + c8 + 4) * z11 + *(const f32x4*)(cw + 2 * D + c8 + 4) * z01;
        *(uint4*)(Bg + (size_t)row * D + c8) = pack8(b0 * y0, b1 * y1);
    }
}

__device__ __forceinline__ void phase_e2(const Params& p, long z, int l) {
    unsigned char* sl = (p.ws + z) + WS_SLOT0; const bf16_t* XC = (const bf16_t*)(sl + 5 * SLOT); bf16_t* Dd = (bf16_t*)(sl + 2 * SLOT);
    const float* sp = (p.state_pool + z) + (size_t)l * TS * 15 * D;
    const f32x4 zero = (f32x4){0.f, 0.f, 0.f, 0.f};
    for (int i = blockIdx.x * 512 + opaque_tid(); i < (T / 16) * 128; i += gridDim.x * 512) {
        const int c8 = (i & 127) * 8, r0 = (i >> 7) * 16, w = 2 << (c8 >> 8);
        if (r0 < TP) {
            const int pos0 = r0 & (SEQ - 1); f32x4 s0 = zero, s1 = zero;
            for (int k = 1; k < w; ++k) if (pos0 - k >= 0) { f32x4 a, b; unpack8(*(const uint4*)(XC + (size_t)(r0 - k) * D + c8), a, b); s0 += a; s1 += b; }
#pragma unroll 1
            for (int t = 0; t < 16; ++t) {
                const int row = r0 + t, pos = pos0 + t; f32x4 a, b; unpack8(*(const uint4*)(XC + (size_t)row * D + c8), a, b);
                s0 += a; s1 += b;
                const float inv = 1.f / (float)(pos + 1 < w ? pos + 1 : w);
                *(uint4*)(Dd + (size_t)row * D + c8) = pack8(s0 * inv - a, s1 * inv - b);
                if (pos >= SEQ - 15) { float* o = (p.out + z) + O_POOLP + (((size_t)l * 8 + (row >> 11)) * 15 + (pos - (SEQ - 15))) * D + c8; *(f32x4*)o = a; *(f32x4*)(o + 4) = b; }
                if (pos - w + 1 >= 0) { f32x4 e, f; unpack8(*(const uint4*)(XC + (size_t)(row - w + 1) * D + c8), e, f); s0 -= e; s1 -= f; }
            }
        } else {
#pragma unroll 1
            for (int t = 0; t < 16; ++t) {
                const int row = r0 + t; f32x4 a = zero, b = zero, d0 = zero, d1 = zero;
                if (row < TV) { const int bi = row - TP; unpack8(*(const uint4*)(XC + (size_t)row * D + c8), a, b);
                    const float* sb = sp + (size_t)bi * 15 * D + c8; f32x4 s0 = a, s1 = b;
                    float* o = (p.out + z) + O_POOLS + ((size_t)l * TS + bi) * 15 * D + c8;
                    for (int j = 14; j >= 0; --j) { const f32x4 e = *(const f32x4*)(sb + (size_t)j * D), f = *(const f32x4*)(sb + (size_t)j * D + 4);
                        if (15 - j < w) { s0 += e; s1 += f; }
                        if (j >= 1) { *(f32x4*)(o + (size_t)(j - 1) * D) = e; *(f32x4*)(o + (size_t)(j - 1) * D + 4) = f; } }
                    *(f32x4*)(o + 14 * D) = a; *(f32x4*)(o + 14 * D + 4) = b;
                    const float inv = 1.f / (float)w; d0 = s0 * inv - a; d1 = s1 * inv - b; }
                *(uint4*)(Dd + (size_t)row * D + c8) = pack8(d0, d1);
            }
        }
    }
}

__device__ __forceinline__ void phase_ln(const float* Y, const float* g, const float* b, bf16_t* ob, float* stats, float* of) {
    const int tid = opaque_tid(), lane = tid & 63, gw = blockIdx.x * 8 + (tid >> 6);
    f32x4 gv[4], bv[4];
#pragma unroll
    for (int j = 0; j < 4; ++j) { gv[j] = *(const f32x4*)(g + j * 256 + lane * 4); bv[j] = *(const f32x4*)(b + j * 256 + lane * 4); }
    for (int row = gw; row < T; row += gridDim.x * 8) {
        f32x4 x[4]; float s = 0.f;
#pragma unroll
        for (int j = 0; j < 4; ++j) { x[j] = *(const f32x4*)(Y + (size_t)row * D + j * 256 + lane * 4); s += x[j][0] + x[j][1] + x[j][2] + x[j][3]; }
        const float mu = wave_sum(s) * (1.f / D); float q = 0.f;
#pragma unroll
        for (int j = 0; j < 4; ++j) { x[j] -= mu; q += x[j][0] * x[j][0] + x[j][1] * x[j][1] + x[j][2] * x[j][2] + x[j][3] * x[j][3]; }
        const float rs = rsqrtf(wave_sum(q) * (1.f / D) + LN_EPS);
        if (stats && lane == 0) { stats[2 * row] = mu; stats[2 * row + 1] = rs; }
#pragma unroll
        for (int j = 0; j < 4; ++j) { const f32x4 y = x[j] * rs * gv[j] + bv[j];
            *(uint2*)(ob + (size_t)row * D + j * 256 + lane * 4) = make_uint2(cvt_pk_bf16(y[0], y[1]), cvt_pk_bf16(y[2], y[3]));
            if (of && row < TV) *(f32x4*)(of + (size_t)row * D + j * 256 + lane * 4) = y; }
    }
}

__global__ void __launch_bounds__(512, 2) mega(Params p) {
    extern __shared__ __attribute__((aligned(16))) unsigned char shm[];
    LAS unsigned char* lds = (LAS unsigned char*)shm;
    cg::grid_group grid = cg::this_grid();
    for (int ph = p.ph0; ph < p.ph1; ++ph) {
        long z = 0; asm volatile("" : "+s"(z));
        unsigned char* ws = p.ws + z; unsigned char* sl = ws + WS_SLOT0;
        if (ph == 0) { phase_convert(p, z, 0, lds); phase_xb(p, z); }
        else {
            const int l = (ph - 1) / 11, k = (ph - 1) % 11;
            switch (k) {
            case 0: { SchedG1 S{(const char*)sl, (const char*)(ws + WS_WIN)}; EpiG1 E{sl}; gemm_phase(lds, S, E); } break;
            case 1: phase_e1(p, z, l, lds); break;
            case 2: phase_e2(p, z, l); break;
            case 3: { { SchedPool S{(const char*)(sl + 2 * SLOT), (const char*)(ws + WS_WPOOL)}; EpiPool E{sl, (p.pool_scale + z) + (size_t)l * D}; gemm_phase(lds, S, E); }
                      { SchedSpat S{(const char*)(ws + WS_WSBD), (const char*)(ws + WS_WSDG), (const char*)(sl + 6 * SLOT)}; EpiSpat E{sl, (p.b_spatial + z) + (size_t)l * 4 * 128}; gemm_phase(lds, S, E); } } break;
            case 4: { SchedGG S{(const char*)sl, (const char*)(ws + WS_WIN)}; EpiGG E{sl}; gemm_phase(lds, S, E); } break;
            case 5: { SchedP3 S{(const char*)sl, (const char*)(ws + WS_WP)}; EpiP3 E{sl}; gemm_phase(lds, S, E); } break;
            case 6: { SchedN4 S{(const char*)sl, (const char*)(ws + WS_WO)};
                      EpiWO E{(float*)(sl + 4 * SLOT), l == 0 ? (p.x_prompt + z) : (p.out + z), l == 0 ? (p.x_sample + z) : (p.out + z) + (size_t)TP * D}; gemm_phase(lds, S, E); } break;
            case 7: phase_ln((const float*)(sl + 4 * SLOT), (p.ln1_g + z) + l * D, (p.ln1_b + z) + l * D, (bf16_t*)(sl + 6 * SLOT), (float*)(ws + WS_STATS), nullptr); break;
            case 8: { SchedFF1 S{(const char*)(sl + 6 * SLOT), (const char*)(ws + WS_W1)}; EpiFF1 E{(bf16_t*)sl}; gemm_phase(lds, S, E); } break;
            case 9: { SchedFF2 S{(const char*)sl, (const char*)(ws + WS_W2)};
                      EpiFF2 E{(float*)(sl + 4 * SLOT), (const float*)(ws + WS_STATS), (p.ln1_g + z) + l * D, (p.ln1_b + z) + l * D}; gemm_phase(lds, S, E); } break;
            case 10: phase_ln((const float*)(sl + 4 * SLOT), (p.ln2_g + z) + l * D, (p.ln2_b + z) + l * D, (bf16_t*)sl, nullptr, (p.out + z));
                     if (l == 0) phase_convert(p, z, 1, lds); break;
            }
        }
        if (ph + 1 < p.ph1) grid.sync();
    }
}

extern "C" void kernel_launch(void* const* d_in, const int* in_sizes, int n_in, void* d_out, int out_size, void* d_ws, size_t ws_size, hipStream_t stream) {
    static int grid = 0;
    if (grid == 0) {
        if (n_in != 23 || ws_size < WS_END) { fprintf(stderr, "kernel_launch: need 23 inputs and >= %zu bytes of workspace; got %d, %zu\n", (size_t)WS_END, n_in, ws_size); grid = -1; return; }
        int dev = 0, cus = 0, per_cu = 0;
        hipGetDevice(&dev); hipDeviceGetAttribute(&cus, hipDeviceAttributeMultiprocessorCount, dev);
        if (hipFuncSetAttribute((const void*)mega, hipFuncAttributeMaxDynamicSharedMemorySize, STAGE_BYTES) != hipSuccess) { fprintf(stderr, "kernel_launch: hipFuncSetAttribute failed\n"); grid = -1; return; }
        if (hipOccupancyMaxActiveBlocksPerMultiprocessor(&per_cu, (const void*)mega, 512, STAGE_BYTES) != hipSuccess || per_cu < 1) { fprintf(stderr, "kernel_launch: occupancy query failed (%d)\n", per_cu); grid = -1; return; }
        grid = cus;
    }
    if (grid < 0) return;
    Params p{};
    const float** pp = (const float**)&p;
    for (int i = 0; i < 23; ++i) pp[i] = (const float*)d_in[i];
    p.out = (float*)d_out; p.ws = (unsigned char*)d_ws; p.ph0 = 0; p.ph1 = 23;
    void* args[] = {&p};
    hipError_t e = hipLaunchCooperativeKernel((const void*)mega, dim3(grid), dim3(512), args, STAGE_BYTES, stream);
    if (e != hipSuccess) fprintf(stderr, "cooperative launch failed: %s (grid %d)\n", hipGetErrorString(e), grid);
}
```

```cpp
#include <hip/hip_runtime.h>
#include <hip/hip_cooperative_groups.h>
#include <cstdio>
namespace cg = cooperative_groups;

#define LAS __attribute__((address_space(3)))
typedef unsigned short bf16_t;
typedef short bf16x8 __attribute__((ext_vector_type(8)));
typedef float f32x4 __attribute__((ext_vector_type(4)));
typedef float f32x2 __attribute__((ext_vector_type(2)));

constexpr int D = 1024, TP = 16384, TS = 128, TV = TP + TS, T = 16640, NMT = TP / 256;
constexpr int DIN = 9216, DFF = 4096, SEQ = 2048;
constexpr float ALPHA = 1.4142135623730951f;
constexpr float LN_EPS = 1e-5f;
constexpr int BM = 256, BK = 64, HALF = 128, HTB = HALF * BK * 2, STAGE_BYTES = 8 * HTB;

constexpr size_t SLOT = (size_t)T * D * 2;
constexpr size_t WS_WIN = 0;
constexpr size_t WS_WP = WS_WIN + (size_t)DIN * D * 2;
constexpr size_t WS_WO = WS_WP + 3ull * D * D * 2;
constexpr size_t WS_W1 = WS_WO + (size_t)D * D * 2;
constexpr size_t WS_W2 = WS_W1 + (size_t)DFF * D * 2;
constexpr size_t WS_WPOOL = WS_W2 + (size_t)DFF * D * 2;
constexpr size_t WS_WSBD = WS_WPOOL + 4ull * 256 * 256 * 2;
constexpr size_t WS_SHC = WS_WSBD + 4ull * 256 * 256 * 2;
constexpr size_t WS_STATS = WS_SHC + (size_t)TS * D * 2;
constexpr size_t WS_SLOT0 = WS_STATS + (size_t)T * 8;
constexpr size_t WS_END = WS_SLOT0 + 7 * SLOT;

constexpr size_t O_Y = 0;
constexpr size_t O_CONVP = (size_t)TV * D;
constexpr size_t O_POOLP = O_CONVP + 2ull * 8 * 2 * D;
constexpr size_t O_CONVS = O_POOLP + 2ull * 8 * 15 * D;
constexpr size_t O_POOLS = O_CONVS + 2ull * 128 * 2 * D;
constexpr size_t O_CHV = O_POOLS + 2ull * 128 * 15 * D;

struct Params {
    const float *x_prompt, *x_sample, *state_conv, *state_pool, *w_in, *lnv_g, *lnv_b, *w_spatial, *b_spatial, *w_proj_a, *conv_w, *conv_b, *w_proj_b,
        *w_pool, *pool_scale, *w_proj_c, *w_o, *ln1_g, *ln1_b, *w_ff1, *w_ff2, *ln2_g, *ln2_b;
    float* out;
    unsigned char* ws;
    int ph0, ph1;
};

__device__ __forceinline__ unsigned short f2bf(float f) { unsigned u = __float_as_uint(f); u += 0x7FFFu + ((u >> 16) & 1u); return (unsigned short)(u >> 16); }
__device__ __forceinline__ unsigned cvt_pk_bf16(float lo, float hi) { unsigned r; asm volatile("v_cvt_pk_bf16_f32 %0, %1, %2" : "=v"(r) : "v"(lo), "v"(hi)); return r; }
__device__ __forceinline__ float bflo(unsigned u) { return __uint_as_float(u << 16); }
__device__ __forceinline__ float bfhi(unsigned u) { return __uint_as_float(u & 0xffff0000u); }
__device__ __forceinline__ uint4 pack8(const f32x4 a, const f32x4 b) { return make_uint4(cvt_pk_bf16(a[0], a[1]), cvt_pk_bf16(a[2], a[3]), cvt_pk_bf16(b[0], b[1]), cvt_pk_bf16(b[2], b[3])); }
__device__ __forceinline__ void unpack8(const uint4 u, f32x4& a, f32x4& b) { a[0] = bflo(u.x); a[1] = bfhi(u.x); a[2] = bflo(u.y); a[3] = bfhi(u.y); b[0] = bflo(u.z); b[1] = bfhi(u.z); b[2] = bflo(u.w); b[3] = bfhi(u.w); }
__device__ __forceinline__ float wave_sum(float v) {
#pragma unroll
    for (int m = 32; m >= 1; m >>= 1) v += __shfl_xor(v, m);
    return v;
}

__device__ __forceinline__ int lds_byte(int r, int c) { const int st = (r >> 4) * 2 + (c >> 5), rr = r & 15, cc = c & 31, ob = rr * 64 + cc * 2; return st * 1024 + (ob ^ (((ob >> 9) & 1) << 5)); }
__device__ __forceinline__ void stage_rc(int b, int& R, int& C) { const int st = b / 1024, sb = b % 1024, swz = sb ^ (((sb >> 9) & 1) << 5); R = (st >> 1) * 16 + swz / 64; C = (st & 1) * 32 + (swz % 64) / 2; }
__device__ __forceinline__ int perm32(int rho) { const int n = rho >> 4, i = rho & 15; return 8 * (i >> 2) + 4 * n + (i & 3); }

__device__ __forceinline__ const char* uni_ptr(const char* p) { unsigned long long v = (unsigned long long)p; unsigned lo = __builtin_amdgcn_readfirstlane((unsigned)v), hi = __builtin_amdgcn_readfirstlane((unsigned)(v >> 32)); asm volatile("" : "+s"(lo), "+s"(hi)); return (const char*)(((unsigned long long)hi << 32) | lo); }
__device__ __forceinline__ int opaque_tid() { int t = threadIdx.x; asm volatile("" : "+v"(t)); return t; }
struct Unit { const char* A; const char* B; unsigned ahs, bhs; int pm, pn, aux; };

__device__ __forceinline__ bool tile_order(int i, int nM, int nN, int& pm, int& pn) {
    int c = blockIdx.x; asm volatile("" : "+s"(c));
    const int G = gridDim.x, nwg = nM * nN;
    const long L = (long)i * G + c; if (L >= nwg) return false;
    int wgid = (int)L; { const int q = nwg / 8, r = nwg % 8, xcd = wgid % 8, off = wgid / 8; wgid = (xcd < r ? xcd * (q + 1) : r * (q + 1) + (xcd - r) * q) + off; }
    const int nig = 8 * nN, gid = wgid / nig, fm = gid * 8, gsz = (nM - fm) < 8 ? (nM - fm) : 8;
    pm = fm + ((wgid % nig) % gsz); pn = (wgid % nig) / gsz; return true;
}

template <class Sched, class Epi>
__device__ __forceinline__ void gemm_phase(LAS unsigned char* lds, const Sched& S, const Epi& E) {
    int tid = threadIdx.x; asm volatile("" : "+v"(tid));
    const int wid = __builtin_amdgcn_readfirstlane(tid >> 6), lane = tid & 63, wr = wid >> 2, wc = wid & 3, fr = lane & 15, fq = lane >> 4;
    constexpr int nt = Sched::NT;
    unsigned vA[2], vB[2];
#pragma unroll
    for (int i = 0; i < 2; ++i) { int R, C; stage_rc(tid * 16 + i * 8192, R, C); vA[i] = (unsigned)R * Sched::LDA2 + (unsigned)(C * 2); vB[i] = (unsigned)((R & ~31) + perm32(R & 31)) * Sched::LDB2 + (unsigned)(C * 2); }
    const size_t kstep = (size_t)(BK * 2);
    const unsigned ldsw = (unsigned)wid * 1024u;
    const int aoff = lds_byte(wr * 64 + fr, fq * 8), boff = lds_byte(wc * 32 + fr, fq * 8);
#define SA_(b, h) (((b) * 2 + (h)) * HTB)
#define SB_(b, h) ((4 + (b) * 2 + (h)) * HTB)
#define STAGE_(bufoff, gbase, voff) do { _Pragma("unroll") for (int _i = 0; _i < 2; ++_i) \
        __builtin_amdgcn_global_load_lds((const unsigned*)((const char*)(gbase) + (voff)[_i]), (LAS unsigned*)(lds + (bufoff) + ldsw + _i * 8192), 16, 0, 0); } while (0)
#define LDA_(dst, b, h) do { _Pragma("unroll") for (int m = 0; m < 4; ++m) _Pragma("unroll") for (int k = 0; k < 2; ++k) dst[m][k] = *(const LAS bf16x8*)(lds + SA_(b, h) + aoff + m * 2048 + k * 1024); } while (0)
#define LDB_(dst, b, h) do { _Pragma("unroll") for (int n = 0; n < 2; ++n) _Pragma("unroll") for (int k = 0; k < 2; ++k) dst[n][k] = *(const LAS bf16x8*)(lds + SB_(b, h) + boff + n * 2048 + k * 1024); } while (0)
#define MMA_(ai, bj, At, Bt) do { __builtin_amdgcn_s_setprio(1); _Pragma("unroll") for (int m = 0; m < 4; ++m) _Pragma("unroll") for (int n = 0; n < 2; ++n) _Pragma("unroll") for (int k = 0; k < 2; ++k) \
        acc[ai][bj][m][n] = __builtin_amdgcn_mfma_f32_16x16x32_bf16(Bt[n][k], At[m][k], acc[ai][bj][m][n], 0, 0, 0); __builtin_amdgcn_s_setprio(0); } while (0)
#define WAIT_V_(n) asm volatile("s_waitcnt vmcnt(" #n ")" ::: "memory")
#define WAIT_L_(n) asm volatile("s_waitcnt lgkmcnt(" #n ")" ::: "memory")
#define BAR_ __builtin_amdgcn_s_barrier()
#define SCHED_ __builtin_amdgcn_sched_barrier(0)
    Unit cur, nxt; int ui = 0;
    if (!S.next(0, cur)) return;
    cur.A = uni_ptr(cur.A); cur.B = uni_ptr(cur.B);
    f32x4 acc[2][2][4][2];
#pragma unroll
    for (int a = 0; a < 2; ++a)
#pragma unroll
        for (int b = 0; b < 2; ++b)
#pragma unroll
            for (int m = 0; m < 4; ++m)
#pragma unroll
                for (int n = 0; n < 2; ++n) acc[a][b][m][n] = (f32x4){0.f, 0.f, 0.f, 0.f};
    bf16x8 At[4][2], B0[2][2], B1[2][2];
    const char* cA = cur.A; const char* cB = cur.B;
    STAGE_(SB_(0, 0), cB, vB); STAGE_(SA_(0, 0), cA, vA); STAGE_(SB_(0, 1), cB + cur.bhs, vB); STAGE_(SA_(0, 1), cA + cur.ahs, vA);
    if (wr == 1) BAR_;
    WAIT_V_(4); BAR_;
    STAGE_(SB_(1, 0), cB + kstep, vB); STAGE_(SA_(1, 0), cA + kstep, vA); STAGE_(SB_(1, 1), cB + cur.bhs + kstep, vB);
    WAIT_V_(6); BAR_;
    for (;;) {
        const bool has_next = S.next(ui + 1, nxt);
        if (!has_next) nxt = cur;
        nxt.A = uni_ptr(nxt.A); nxt.B = uni_ptr(nxt.B);
        const char* nA = nxt.A; const char* nB = nxt.B;
#pragma unroll 1
        for (int t = 0; t < nt; t += 2) {
            const bool last = (t == nt - 2);
            const char* a1 = cA + (size_t)(t + 1) * kstep;
            const char* a2 = last ? nA : cA + (size_t)(t + 2) * kstep; const char* b2 = last ? nB : cB + (size_t)(t + 2) * kstep;
            const char* a3 = a2 + kstep; const char* b3 = b2 + kstep;
            const unsigned ahs2 = last ? nxt.ahs : cur.ahs, bhs2 = last ? nxt.bhs : cur.bhs;
            LDB_(B0, 0, 0); SCHED_; LDA_(At, 0, 0); STAGE_(SA_(1, 1), a1 + cur.ahs, vA);
            WAIT_L_(8); BAR_; WAIT_L_(0); MMA_(0, 0, At, B0); BAR_; SCHED_;
            LDB_(B1, 0, 1); STAGE_(SB_(0, 0), b2, vB);
            BAR_; WAIT_L_(0); MMA_(0, 1, At, B1); BAR_;
            LDA_(At, 0, 1); STAGE_(SA_(0, 0), a2, vA);
            BAR_; WAIT_L_(0); MMA_(1, 0, At, B0); BAR_; SCHED_;
            STAGE_(SB_(0, 1), b2 + bhs2, vB);
            WAIT_V_(6); BAR_; MMA_(1, 1, At, B1); BAR_;
            LDB_(B0, 1, 0); SCHED_; LDA_(At, 1, 0); STAGE_(SA_(0, 1), a2 + ahs2, vA);
            WAIT_L_(8); BAR_; WAIT_L_(0); MMA_(0, 0, At, B0); BAR_; SCHED_;
            LDB_(B1, 1, 1); STAGE_(SB_(1, 0), b3, vB);
            BAR_; WAIT_L_(0); MMA_(0, 1, At, B1); BAR_;
            LDA_(At, 1, 1); STAGE_(SA_(1, 0), a3, vA);
            BAR_; WAIT_L_(0); MMA_(1, 0, At, B0); BAR_; SCHED_;
            STAGE_(SB_(1, 1), b3 + bhs2, vB);
            WAIT_V_(6); BAR_; MMA_(1, 1, At, B1); BAR_;
        }
        int fr2 = fr, fq2 = fq; asm volatile("" : "+v"(fr2), "+v"(fq2));
        const bool fin = E.finish(acc, cur, wr, wc, fr2, fq2);
        if (!has_next) break;
        if (fin) {
#pragma unroll
            for (int a = 0; a < 2; ++a)
#pragma unroll
                for (int b = 0; b < 2; ++b)
#pragma unroll
                    for (int m = 0; m < 4; ++m)
#pragma unroll
                        for (int n = 0; n < 2; ++n) acc[a][b][m][n] = (f32x4){0.f, 0.f, 0.f, 0.f};
        }
        cur = nxt; cA = nA; cB = nB; ++ui;
    }
    WAIT_V_(0);
    if (wr == 0) BAR_;
    BAR_;
#undef SA_
#undef SB_
#undef STAGE_
#undef LDA_
#undef LDB_
#undef MMA_
#undef WAIT_V_
#undef WAIT_L_
#undef BAR_
#undef SCHED_
}

#define ACC_T f32x4 (&acc)[2][2][4][2]
#define ROW_(u, ai, m) ((u).pm * 256 + (ai) * 128 + wr * 64 + (m) * 16 + fr)

struct SchedG1 {
    static constexpr int NT = 16; static constexpr unsigned LDA2 = 2048, LDB2 = 2048; const char *xb, *win;
    __device__ __forceinline__ bool next(int i, Unit& u) const {
        int pm, pn; if (!tile_order(i, NMT, 24, pm, pn)) return false;
        u.pm = pm; u.pn = pn; u.aux = 0; u.A = xb + (size_t)pm * 256 * 2048; u.ahs = 128 * 2048;
        if (pn < 12) { u.B = win + (size_t)pn * 256 * 2048; u.bhs = 128 * 2048; }
        else if (pn < 20) { u.B = win + (size_t)(3072 + 128 * (pn - 12)) * 2048; u.bhs = 1024 * 2048; }
        else { u.B = win + (size_t)(5120 + 256 * (pn - 20)) * 2048; u.bhs = 128 * 2048; }
        return true;
    }
};
struct EpiG1 {
    unsigned char* slots;
    __device__ __forceinline__ bool finish(ACC_T, const Unit& u, int wr, int wc, int fr, int fq) const {
        const int ct = u.pn;
        if (ct >= 12 && ct < 20) {
            bf16_t* o = (bf16_t*)(slots + 4 * SLOT) + 128 * (ct - 12) + wc * 32 + 8 * fq;
#pragma unroll
            for (int ai = 0; ai < 2; ++ai)
#pragma unroll
                for (int m = 0; m < 4; ++m) { const size_t row = ROW_(u, ai, m);
                    *(uint4*)(o + row * D) = pack8(acc[ai][0][m][0] * acc[ai][1][m][0], acc[ai][0][m][1] * acc[ai][1][m][1]); }
        } else {
            const int sl = ct < 12 ? 1 + (ct >> 2) : 5, ctile = ct < 12 ? (ct & 3) : ct - 20;
            bf16_t* o = (bf16_t*)(slots + (size_t)sl * SLOT) + ctile * 256 + wc * 32 + 8 * fq;
#pragma unroll
            for (int ai = 0; ai < 2; ++ai)
#pragma unroll
                for (int m = 0; m < 4; ++m) { const size_t row = ROW_(u, ai, m);
#pragma unroll
                    for (int bj = 0; bj < 2; ++bj) *(uint4*)(o + row * D + bj * 128) = pack8(acc[ai][bj][m][0], acc[ai][bj][m][1]); }
        }
        return true;
    }
};

struct SchedSpat {
    static constexpr int NT = 4; static constexpr unsigned LDA2 = 512, LDB2 = T * 2; const char *wsbd, *vnT;
    __device__ __forceinline__ bool next(int i, Unit& u) const {
        int c = blockIdx.x; asm volatile("" : "+s"(c)); const long L = (long)i * gridDim.x + c; if (L >= NMT * 4) return false;
        const int pm = (int)L >> 2, g = (int)L & 3; u.pm = pm; u.pn = g; u.aux = 0;
        u.A = wsbd + (size_t)g * 256 * 512; u.ahs = 128 * 512;
        u.B = vnT + ((size_t)g * 256 * T + (size_t)pm * 256) * 2; u.bhs = 128u * T * 2; return true;
    }
};
struct SchedPool {
    static constexpr int NT = 4; static constexpr unsigned LDA2 = 2048, LDB2 = 512; const char *dbuf, *wpoolT;
    __device__ __forceinline__ bool next(int i, Unit& u) const {
        int c = blockIdx.x; asm volatile("" : "+s"(c)); const long L = (long)i * gridDim.x + c; if (L >= NMT * 4) return false;
        const int pm = (int)L >> 2, g = (int)L & 3; u.pm = pm; u.pn = g; u.aux = 1;
        u.A = dbuf + ((size_t)pm * 256 * D + g * 256) * 2; u.ahs = 128 * 2048;
        u.B = wpoolT + (size_t)g * 256 * 512; u.bhs = 128 * 512; return true;
    }
};
struct EpiSpat {
    unsigned char* slots; const float* bsp;
    __device__ __forceinline__ bool finish(ACC_T, const Unit& u, int wr, int wc, int fr, int fq) const {
        const int g = u.pn;
        bf16_t* o = (bf16_t*)(slots + 1 * SLOT) + g * 256 + wc * 32 + 8 * fq;
#pragma unroll
        for (int ai = 0; ai < 2; ++ai)
#pragma unroll
            for (int m = 0; m < 4; ++m) { const int row = ROW_(u, ai, m); const float bs = bsp[g * 128 + (row & 127)];
#pragma unroll
                for (int bj = 0; bj < 2; ++bj) { bf16_t* q = o + (size_t)row * D + bj * 128; f32x4 u0, u1; unpack8(*(const uint4*)q, u0, u1);
                    *(uint4*)q = pack8(u0 * (acc[ai][bj][m][0] + bs), u1 * (acc[ai][bj][m][1] + bs)); }
                if (m & 1) { asm volatile("" ::: "memory"); __builtin_amdgcn_sched_barrier(0); } }
        return true;
    }
};
struct EpiPool {
    unsigned char* slots; const float* pscale;
    __device__ __forceinline__ bool finish(ACC_T, const Unit& u, int wr, int wc, int fr, int fq) const {
        const int g = u.pn;
        bf16_t* o = (bf16_t*)(slots + 2 * SLOT) + g * 256 + wc * 32 + 8 * fq;
        f32x4 sc[2][2];
#pragma unroll
        for (int bj = 0; bj < 2; ++bj)
#pragma unroll
            for (int n = 0; n < 2; ++n) sc[bj][n] = *(const f32x4*)(pscale + g * 256 + bj * 128 + wc * 32 + 8 * fq + 4 * n);
#pragma unroll
        for (int ai = 0; ai < 2; ++ai)
#pragma unroll
            for (int m = 0; m < 4; ++m) { const size_t row = ROW_(u, ai, m);
#pragma unroll
                for (int bj = 0; bj < 2; ++bj) *(uint4*)(o + row * D + bj * 128) = pack8(acc[ai][bj][m][0] * sc[bj][0], acc[ai][bj][m][1] * sc[bj][1]); }
        return true;
    }
};

struct SchedGG {
    static constexpr int NT = 16; static constexpr unsigned LDA2 = 2048, LDB2 = 2048; const char *xb, *win;
    __device__ __forceinline__ bool next(int i, Unit& u) const {
        int pm, pn; if (!tile_order(i, NMT, 12, pm, pn)) return false;
        u.pm = pm; u.pn = pn; u.aux = 0; u.A = xb + (size_t)pm * 256 * 2048; u.ahs = 128 * 2048;
        u.B = win + (size_t)(6144 + 256 * pn) * 2048; u.bhs = 128 * 2048; return true;
    }
};
struct EpiGG {
    unsigned char* slots;
    __device__ __forceinline__ bool finish(ACC_T, const Unit& u, int wr, int wc, int fr, int fq) const {
        bf16_t* o = (bf16_t*)(slots + (size_t)(4 + (u.pn >> 2)) * SLOT) + (u.pn & 3) * 256 + wc * 32 + 8 * fq;
#pragma unroll
        for (int ai = 0; ai < 2; ++ai)
#pragma unroll
            for (int m = 0; m < 4; ++m) { const size_t row = ROW_(u, ai, m);
#pragma unroll
                for (int bj = 0; bj < 2; ++bj) { f32x4 s0, s1;
#pragma unroll
                    for (int k = 0; k < 4; ++k) { s0[k] = 1.f / (1.f + __expf(-acc[ai][bj][m][0][k])); s1[k] = 1.f / (1.f + __expf(-acc[ai][bj][m][1][k])); }
                    *(uint4*)(o + row * D + bj * 128) = pack8(s0, s1); } }
        return true;
    }
};

struct SchedP3 {
    static constexpr int NT = 16; static constexpr unsigned LDA2 = 2048, LDB2 = 2048; const char *slots, *wp;
    __device__ __forceinline__ bool next(int i, Unit& u) const {
        const int un = i / 3, seg = i - un * 3; int pm, pn; if (!tile_order(un, NMT, 4, pm, pn)) return false;
        u.pm = pm; u.pn = pn; u.aux = seg; const int sl = seg == 0 ? 1 : (seg == 1 ? 3 : 2);
        u.A = slots + (size_t)sl * SLOT + (size_t)pm * 256 * 2048; u.ahs = 128 * 2048;
        u.B = wp + ((size_t)seg * 1024 + pn * 256) * 2048; u.bhs = 128 * 2048; return true;
    }
};
struct EpiP3 {
    unsigned char* slots;
    __device__ __forceinline__ bool finish(ACC_T, const Unit& u, int wr, int wc, int fr, int fq) const {
        const int seg = u.aux; const size_t cofs = (size_t)u.pn * 256 + wc * 32 + 8 * fq;
        const bf16_t* ga = (const bf16_t*)(slots + (size_t)(4 + seg) * SLOT) + cofs;
        bf16_t* o = (bf16_t*)(slots) + cofs;
#pragma unroll
        for (int ai = 0; ai < 2; ++ai)
#pragma unroll
            for (int m = 0; m < 4; ++m) { const size_t row = ROW_(u, ai, m);
#pragma unroll
                for (int bj = 0; bj < 2; ++bj) { f32x4 a0, a1; unpack8(*(const uint4*)(ga + row * D + bj * 128), a0, a1);
                    f32x4 v0 = acc[ai][bj][m][0] * a0, v1 = acc[ai][bj][m][1] * a1;
                    if (seg > 0) { f32x4 p0, p1; unpack8(*(const uint4*)(o + row * D + bj * 128), p0, p1); v0 += p0; v1 += p1; }
                    *(uint4*)(o + row * D + bj * 128) = pack8(v0, v1); }
                if (m & 1) { asm volatile("" ::: "memory"); __builtin_amdgcn_sched_barrier(0); } }
        return true;
    }
};

struct SchedN4 {
    static constexpr int NT = 16; static constexpr unsigned LDA2 = 2048, LDB2 = 2048; const char *A, *B;
    __device__ __forceinline__ bool next(int i, Unit& u) const {
        int pm, pn; if (!tile_order(i, NMT, 4, pm, pn)) return false;
        u.pm = pm; u.pn = pn; u.aux = 0; u.A = A + (size_t)pm * 256 * 2048; u.ahs = 128 * 2048; u.B = B + (size_t)pn * 256 * 2048; u.bhs = 128 * 2048; return true;
    }
};
struct EpiWO {
    float* y1; const float *xa, *xb_;
    __device__ __forceinline__ bool finish(ACC_T, const Unit& u, int wr, int wc, int fr, int fq) const {
        const int c0 = u.pn * 256 + wc * 32 + 8 * fq;
#pragma unroll
        for (int ai = 0; ai < 2; ++ai)
#pragma unroll
            for (int m = 0; m < 4; ++m) { const int row = ROW_(u, ai, m); const float* xr = row < TP ? xa + (size_t)row * D : xb_ + (size_t)(row - TP) * D; const bool ok = row < TV;
#pragma unroll
                for (int bj = 0; bj < 2; ++bj)
#pragma unroll
                    for (int n = 0; n < 2; ++n) { const int c = c0 + bj * 128 + 4 * n; f32x4 xv = (f32x4){0.f, 0.f, 0.f, 0.f}; if (ok) xv = *(const f32x4*)(xr + c);
                        *(f32x4*)(y1 + (size_t)row * D + c) = xv * ALPHA + acc[ai][bj][m][n]; }
                if (m & 1) { asm volatile("" ::: "memory"); __builtin_amdgcn_sched_barrier(0); } }
        return true;
    }
};

struct SchedFF1 {
    static constexpr int NT = 16; static constexpr unsigned LDA2 = 2048, LDB2 = 2048; const char *A, *B;
    __device__ __forceinline__ bool next(int i, Unit& u) const {
        int pm, pn; if (!tile_order(i, NMT, 16, pm, pn)) return false;
        u.pm = pm; u.pn = pn; u.aux = 0; u.A = A + (size_t)pm * 256 * 2048; u.ahs = 128 * 2048; u.B = B + (size_t)pn * 256 * 2048; u.bhs = 128 * 2048; return true;
    }
};
struct EpiFF1 {
    bf16_t* f1;
    __device__ __forceinline__ bool finish(ACC_T, const Unit& u, int wr, int wc, int fr, int fq) const {
        bf16_t* o = f1 + u.pn * 256 + wc * 32 + 8 * fq;
#pragma unroll
        for (int ai = 0; ai < 2; ++ai)
#pragma unroll
            for (int m = 0; m < 4; ++m) { const size_t row = ROW_(u, ai, m);
#pragma unroll
                for (int bj = 0; bj < 2; ++bj) { f32x4 s0, s1;
#pragma unroll
                    for (int k = 0; k < 4; ++k) { const float a = fmaxf(acc[ai][bj][m][0][k], 0.f), b = fmaxf(acc[ai][bj][m][1][k], 0.f); s0[k] = a * a; s1[k] = b * b; }
                    *(uint4*)(o + row * DFF + bj * 128) = pack8(s0, s1); } }
        return true;
    }
};

struct SchedFF2 {
    static constexpr int NT = 64; static constexpr unsigned LDA2 = 8192, LDB2 = 8192; const char *A, *B;
    __device__ __forceinline__ bool next(int i, Unit& u) const {
        int pm, pn; if (!tile_order(i, NMT, 4, pm, pn)) return false;
        u.pm = pm; u.pn = pn; u.aux = 0; u.A = A + (size_t)pm * 256 * 8192; u.ahs = 128 * 8192; u.B = B + (size_t)pn * 256 * 8192; u.bhs = 128 * 8192; return true;
    }
};
struct EpiFF2 {
    float* y1; const float* stats; const float *g, *b;
    __device__ __forceinline__ bool finish(ACC_T, const Unit& u, int wr, int wc, int fr, int fq) const {
        const int c0 = u.pn * 256 + wc * 32 + 8 * fq;
        f32x4 gv[2][2], bv[2][2];
#pragma unroll
        for (int bj = 0; bj < 2; ++bj)
#pragma unroll
            for (int n = 0; n < 2; ++n) { gv[bj][n] = *(const f32x4*)(g + c0 + bj * 128 + 4 * n); bv[bj][n] = *(const f32x4*)(b + c0 + bj * 128 + 4 * n); }
#pragma unroll
        for (int ai = 0; ai < 2; ++ai)
#pragma unroll
            for (int m = 0; m < 4; ++m) { const int row = ROW_(u, ai, m); const float mu = stats[2 * row], rs = stats[2 * row + 1];
#pragma unroll
                for (int bj = 0; bj < 2; ++bj)
#pragma unroll
                    for (int n = 0; n < 2; ++n) { float* q = y1 + (size_t)row * D + c0 + bj * 128 + 4 * n; const f32x4 y = *(const f32x4*)q;
                        const f32x4 h = (y - mu) * rs * gv[bj][n] + bv[bj][n]; *(f32x4*)q = h * ALPHA + acc[ai][bj][m][n]; }
                if (m & 1) { asm volatile("" ::: "memory"); __builtin_amdgcn_sched_barrier(0); } }
        return true;
    }
};

__device__ __forceinline__ void conv_tile(const float* src, int N, bf16_t* dst, int K, int k0, int n0, LAS unsigned short* tile) {
    const int tid = opaque_tid();
#pragma unroll
    for (int i = 0; i < 2; ++i) { const int k = (tid >> 4) + 32 * i, n4 = (tid & 15) * 4; const float4 v = *(const float4*)(src + (size_t)(k0 + k) * N + n0 + n4);
        tile[(n4 + 0) * 66 + k] = f2bf(v.x); tile[(n4 + 1) * 66 + k] = f2bf(v.y); tile[(n4 + 2) * 66 + k] = f2bf(v.z); tile[(n4 + 3) * 66 + k] = f2bf(v.w); }
    __syncthreads();
    { const int n = tid >> 3, k8 = (tid & 7) * 8; const LAS unsigned* s = (const LAS unsigned*)(tile + n * 66 + k8);
        *(uint4*)(dst + (size_t)(n0 + n) * K + k0 + k8) = make_uint4(s[0], s[1], s[2], s[3]); }
    __syncthreads();
}

__device__ __forceinline__ void phase_convert(const Params& p, long z, int l, LAS unsigned char* lds) {
    unsigned char* ws = (p.ws + z); LAS unsigned short* tile = (LAS unsigned short*)lds;
    for (int t = blockIdx.x; t < 5440; t += gridDim.x) {
        const float* src; bf16_t* dst; int K, N, tt;
        if (t < 2304) { tt = t; src = (p.w_in + z) + (size_t)l * D * DIN; K = D; N = DIN; dst = (bf16_t*)(ws + WS_WIN); }
        else if (t < 3072) { const int i = (t - 2304) >> 8; tt = (t - 2304) & 255; src = (i == 0 ? (p.w_proj_a + z) : (i == 1 ? (p.w_proj_b + z) : (p.w_proj_c + z))) + (size_t)l * D * D; K = D; N = D; dst = (bf16_t*)(ws + WS_WP) + (size_t)i * D * D; }
        else if (t < 3328) { tt = t - 3072; src = (p.w_o + z) + (size_t)l * D * D; K = D; N = D; dst = (bf16_t*)(ws + WS_WO); }
        else if (t < 4352) { tt = t - 3328; src = (p.w_ff1 + z) + (size_t)l * D * DFF; K = D; N = DFF; dst = (bf16_t*)(ws + WS_W1); }
        else if (t < 5376) { tt = t - 4352; src = (p.w_ff2 + z) + (size_t)l * D * DFF; K = DFF; N = D; dst = (bf16_t*)(ws + WS_W2); }
        else { const int g = (t - 5376) >> 4; tt = (t - 5376) & 15; src = (p.w_pool + z) + ((size_t)l * 4 + g) * 65536; K = 256; N = 256; dst = (bf16_t*)(ws + WS_WPOOL) + (size_t)g * 65536; }
        const int nkt = K / 64, kt = tt % nkt, ntile = tt / nkt;
        conv_tile(src, N, dst, K, kt * 64, ntile * 64, tile);
    }
    const float* wsp = (p.w_spatial + z) + (size_t)l * 4 * 128 * 128;
    bf16_t* bd = (bf16_t*)(ws + WS_WSBD);
    for (int i = blockIdx.x * 512 + opaque_tid(); i < 4 * 65536; i += gridDim.x * 512) {
        const int g = i >> 16, r = (i >> 8) & 255, c = i & 255;
        const bool on = ((r >> 7) == (c >> 7)) && ((c & 127) <= (r & 127));
        bd[i] = on ? f2bf(wsp[g * 16384 + (r & 127) * 128 + (c & 127)]) : (bf16_t)0;
    }
}

__device__ __forceinline__ void phase_xb(const Params& p, long z) {
    bf16_t* xb = (bf16_t*)((p.ws + z) + WS_SLOT0);
    for (int i = blockIdx.x * 512 + opaque_tid(); i < T * 128; i += gridDim.x * 512) {
        const int row = i >> 7, c8 = (i & 127) * 8; uint4 o = make_uint4(0, 0, 0, 0);
        if (row < TV) { const float* s = (row < TP ? (p.x_prompt + z) + (size_t)row * D : (p.x_sample + z) + (size_t)(row - TP) * D) + c8; const float4 a = *(const float4*)s, b = *(const float4*)(s + 4);
            o = make_uint4(cvt_pk_bf16(a.x, a.y), cvt_pk_bf16(a.z, a.w), cvt_pk_bf16(b.x, b.y), cvt_pk_bf16(b.z, b.w)); }
        *(uint4*)(xb + (size_t)row * D + c8) = o;
    }
}

__device__ __forceinline__ void phase_e1(const Params& p, long z, int l, LAS unsigned char* lds) {
    unsigned char* sl = (p.ws + z) + WS_SLOT0; const int tid = opaque_tid(), wid = tid >> 6, lane = tid & 63;
    const bf16_t* V = (const bf16_t*)(sl + 2 * SLOT); bf16_t* vnT = (bf16_t*)(sl + 6 * SLOT);
    LAS unsigned short* tile = (LAS unsigned short*)lds;
    const float* lg = (p.lnv_g + z) + l * D + lane * 16; const float* lb = (p.lnv_b + z) + l * D + lane * 16;
    for (int task = blockIdx.x; task < TV / 32; task += gridDim.x) {
        const int r0 = task * 32;
#pragma unroll 1
        for (int rr = 0; rr < 4; ++rr) {
            const int lr = wid * 4 + rr, row = r0 + lr;
            const uint4 a = *(const uint4*)(V + (size_t)row * D + lane * 16), b = *(const uint4*)(V + (size_t)row * D + lane * 16 + 8);
            f32x4 x0, x1, x2, x3; unpack8(a, x0, x1); unpack8(b, x2, x3);
            float s = 0.f;
#pragma unroll
            for (int k = 0; k < 4; ++k) s += x0[k] + x1[k] + x2[k] + x3[k];
            const float mu = wave_sum(s) * (1.f / D);
            x0 -= mu; x1 -= mu; x2 -= mu; x3 -= mu;
            float q = 0.f;
#pragma unroll
            for (int k = 0; k < 4; ++k) q += x0[k] * x0[k] + x1[k] * x1[k] + x2[k] * x2[k] + x3[k] * x3[k];
            const float rs = rsqrtf(wave_sum(q) * (1.f / D) + LN_EPS);
            x0 = x0 * rs * *(const f32x4*)(lg) + *(const f32x4*)(lb); x1 = x1 * rs * *(const f32x4*)(lg + 4) + *(const f32x4*)(lb + 4);
            x2 = x2 * rs * *(const f32x4*)(lg + 8) + *(const f32x4*)(lb + 8); x3 = x3 * rs * *(const f32x4*)(lg + 12) + *(const f32x4*)(lb + 12);
            LAS unsigned* tw = (LAS unsigned*)(tile + lr * 1026 + lane * 16);
            const uint4 o0 = pack8(x0, x1), o1 = pack8(x2, x3);
            tw[0] = o0.x; tw[1] = o0.y; tw[2] = o0.z; tw[3] = o0.w; tw[4] = o1.x; tw[5] = o1.y; tw[6] = o1.z; tw[7] = o1.w;
            if (row >= TP) { float* cv = (p.out + z) + O_CHV + ((size_t)l * TS + (row - TP)) * D + lane * 16;
                *(f32x4*)cv = x0; *(f32x4*)(cv + 4) = x1; *(f32x4*)(cv + 8) = x2; *(f32x4*)(cv + 12) = x3;
                const int g = lane >> 4; const float w00 = (p.w_spatial + z)[((size_t)l * 4 + g) * 16384], b0 = (p.b_spatial + z)[((size_t)l * 4 + g) * 128];
                bf16_t* up = (bf16_t*)(sl + 1 * SLOT) + (size_t)row * D + lane * 16; f32x4 u0, u1, u2, u3; unpack8(*(const uint4*)up, u0, u1); unpack8(*(const uint4*)(up + 8), u2, u3);
                *(uint4*)up = pack8(u0 * (x0 * w00 + b0), u1 * (x1 * w00 + b0)); *(uint4*)(up + 8) = pack8(u2 * (x2 * w00 + b0), u3 * (x3 * w00 + b0)); }
        }
        __syncthreads();
#pragma unroll 1
        for (int j = 0; j < 2; ++j) {
            const int c = tid + 512 * j; unsigned w[16];
#pragma unroll
            for (int t2 = 0; t2 < 16; ++t2) w[t2] = (unsigned)tile[(2 * t2) * 1026 + c] | ((unsigned)tile[(2 * t2 + 1) * 1026 + c] << 16);
            uint4* o = (uint4*)(vnT + (size_t)c * T + r0);
            o[0] = make_uint4(w[0], w[1], w[2], w[3]); o[1] = make_uint4(w[4], w[5], w[6], w[7]); o[2] = make_uint4(w[8], w[9], w[10], w[11]); o[3] = make_uint4(w[12], w[13], w[14], w[15]);
        }
        __syncthreads();
    }
    bf16_t* Bg = (bf16_t*)(sl + 3 * SLOT); const bf16_t* Z = (const bf16_t*)(sl + 4 * SLOT);
    const float* cw = (p.conv_w + z) + (size_t)l * 3 * D; const float* cb = (p.conv_b + z) + (size_t)l * D; const float* sc = (p.state_conv + z) + (size_t)l * TS * 2 * D;
    for (int i = blockIdx.x * 512 + tid; i < TV * 128; i += gridDim.x * 512) {
        const int row = i >> 7, c8 = (i & 127) * 8;
        f32x4 b0, b1, z00, z01, z10, z11, z20, z21;
        const f32x4 zero = (f32x4){0.f, 0.f, 0.f, 0.f};
        unpack8(*(const uint4*)(Bg + (size_t)row * D + c8), b0, b1);
        unpack8(*(const uint4*)(Z + (size_t)row * D + c8), z00, z01);
        z10 = z11 = z20 = z21 = zero;
        if (row < TP) { const int pos = row & (SEQ - 1);
            if (pos >= 1) unpack8(*(const uint4*)(Z + (size_t)(row - 1) * D + c8), z10, z11);
            if (pos >= 2) unpack8(*(const uint4*)(Z + (size_t)(row - 2) * D + c8), z20, z21);
            if (pos >= SEQ - 2) { float* o = (p.out + z) + O_CONVP + (((size_t)l * 8 + (row >> 11)) * 2 + (pos - (SEQ - 2))) * D + c8; *(f32x4*)o = z00; *(f32x4*)(o + 4) = z01; }
        } else if (row < TV) { const int bi = row - TP; const float* s0 = sc + (size_t)bi * 2 * D + c8;
            z20 = *(const f32x4*)s0; z21 = *(const f32x4*)(s0 + 4); z10 = *(const f32x4*)(s0 + D); z11 = *(const f32x4*)(s0 + D + 4);
            float* o = (p.out + z) + O_CONVS + ((size_t)l * TS + bi) * 2 * D + c8; *(f32x4*)o = z10; *(f32x4*)(o + 4) = z11; *(f32x4*)(o + D) = z00; *(f32x4*)(o + D + 4) = z01; }
        const f32x4 y0 = *(const f32x4*)(cb + c8) + *(const f32x4*)(cw + c8) * z20 + *(const f32x4*)(cw + D + c8) * z10 + *(const f32x4*)(cw + 2 * D + c8) * z00;
        const f32x4 y1 = *(const f32x4*)(cb + c8 + 4) + *(const f32x4*)(cw + c8 + 4) * z21 + *(const f32x4*)(cw + D + c8 + 4) * z11 + *(const f32x4*)(cw + 2 * D + c8 + 4) * z01;
        *(uint4*)(Bg + (size_t)row * D + c8) = pack8(b0 * y0, b1 * y1);
    }
}

__device__ __forceinline__ void phase_e2(const Params& p, long z, int l) {
    unsigned char* sl = (p.ws + z) + WS_SLOT0; const bf16_t* XC = (const bf16_t*)(sl + 5 * SLOT); bf16_t* Dd = (bf16_t*)(sl + 2 * SLOT);
    const float* sp = (p.state_pool + z) + (size_t)l * TS * 15 * D;
    const f32x4 zero = (f32x4){0.f, 0.f, 0.f, 0.f};
    for (int i = blockIdx.x * 512 + opaque_tid(); i < (TV / 16) * 128; i += gridDim.x * 512) {
        const int c8 = (i & 127) * 8, r0 = (i >> 7) * 16, w = 2 << (c8 >> 8);
        if (r0 < TP) {
            const int pos0 = r0 & (SEQ - 1); f32x4 s0 = zero, s1 = zero;
            for (int k = 1; k < w; ++k) if (pos0 - k >= 0) { f32x4 a, b; unpack8(*(const uint4*)(XC + (size_t)(r0 - k) * D + c8), a, b); s0 += a; s1 += b; }
#pragma unroll 1
            for (int t = 0; t < 16; ++t) {
                const int row = r0 + t, pos = pos0 + t; f32x4 a, b; unpack8(*(const uint4*)(XC + (size_t)row * D + c8), a, b);
                s0 += a; s1 += b;
                const float inv = 1.f / (float)(pos + 1 < w ? pos + 1 : w);
                *(uint4*)(Dd + (size_t)row * D + c8) = pack8(s0 * inv - a, s1 * inv - b);
                if (pos >= SEQ - 15) { float* o = (p.out + z) + O_POOLP + (((size_t)l * 8 + (row >> 11)) * 15 + (pos - (SEQ - 15))) * D + c8; *(f32x4*)o = a; *(f32x4*)(o + 4) = b; }
                if (pos - w + 1 >= 0) { f32x4 e, f; unpack8(*(const uint4*)(XC + (size_t)(row - w + 1) * D + c8), e, f); s0 -= e; s1 -= f; }
            }
        } else {
#pragma unroll 1
            for (int t = 0; t < 16; ++t) {
                const int row = r0 + t; f32x4 a = zero, b = zero, d0 = zero, d1 = zero;
                if (row < TV) { const int bi = row - TP; unpack8(*(const uint4*)(XC + (size_t)row * D + c8), a, b);
                    const float* sb = sp + (size_t)bi * 15 * D + c8; f32x4 s0 = a, s1 = b;
                    float* o = (p.out + z) + O_POOLS + ((size_t)l * TS + bi) * 15 * D + c8;
                    for (int j = 14; j >= 0; --j) { const f32x4 e = *(const f32x4*)(sb + (size_t)j * D), f = *(const f32x4*)(sb + (size_t)j * D + 4);
                        if (15 - j < w) { s0 += e; s1 += f; }
                        if (j >= 1) { *(f32x4*)(o + (size_t)(j - 1) * D) = e; *(f32x4*)(o + (size_t)(j - 1) * D + 4) = f; } }
                    *(f32x4*)(o + 14 * D) = a; *(f32x4*)(o + 14 * D + 4) = b;
                    const float inv = 1.f / (float)w; d0 = s0 * inv - a; d1 = s1 * inv - b; }
                *(uint4*)(Dd + (size_t)row * D + c8) = pack8(d0, d1);
            }
        }
    }
}

__device__ __forceinline__ void phase_ln(const float* Y, const float* g, const float* b, bf16_t* ob, float* stats, float* of) {
    const int tid = opaque_tid(), lane = tid & 63, gw = blockIdx.x * 8 + (tid >> 6);
    f32x4 gv[4], bv[4];
#pragma unroll
    for (int j = 0; j < 4; ++j) { gv[j] = *(const f32x4*)(g + j * 256 + lane * 4); bv[j] = *(const f32x4*)(b + j * 256 + lane * 4); }
    for (int row = gw; row < TV; row += gridDim.x * 8) {
        f32x4 x[4]; float s = 0.f;
#pragma unroll
        for (int j = 0; j < 4; ++j) { x[j] = *(const f32x4*)(Y + (size_t)row * D + j * 256 + lane * 4); s += x[j][0] + x[j][1] + x[j][2] + x[j][3]; }
        const float mu = wave_sum(s) * (1.f / D); float q = 0.f;
#pragma unroll
        for (int j = 0; j < 4; ++j) { x[j] -= mu; q += x[j][0] * x[j][0] + x[j][1] * x[j][1] + x[j][2] * x[j][2] + x[j][3] * x[j][3]; }
        const float rs = rsqrtf(wave_sum(q) * (1.f / D) + LN_EPS);
        if (stats && lane == 0) { stats[2 * row] = mu; stats[2 * row + 1] = rs; }
#pragma unroll
        for (int j = 0; j < 4; ++j) { const f32x4 y = x[j] * rs * gv[j] + bv[j];
            *(uint2*)(ob + (size_t)row * D + j * 256 + lane * 4) = make_uint2(cvt_pk_bf16(y[0], y[1]), cvt_pk_bf16(y[2], y[3]));
            if (of && row < TV) *(f32x4*)(of + (size_t)row * D + j * 256 + lane * 4) = y; }
    }
}


__device__ __forceinline__ float2 sk_tile(LAS float* red, const bf16_t* A, int lda, const bf16_t* Bt, int ldb, int K, int tid) {
    const int wid = tid >> 6, lane = tid & 63, fr = lane & 15, fq = lane >> 4, kw = K >> 3, kq = kw >> 2;
    const bf16_t* a0 = A + (size_t)fr * lda + wid * kw + fq * kq; const bf16_t* a1 = a0 + (size_t)16 * lda;
    const bf16_t* b0 = Bt + (size_t)fr * ldb + wid * kw + fq * kq; const bf16_t* b1 = b0 + (size_t)16 * ldb;
    f32x4 c00 = (f32x4){0.f, 0.f, 0.f, 0.f}, c01 = c00, c10 = c00, c11 = c00;
#pragma unroll 4
    for (int s = 0; s < kq; s += 8) {
        const bf16x8 av0 = *(const bf16x8*)(a0 + s), av1 = *(const bf16x8*)(a1 + s), bv0 = *(const bf16x8*)(b0 + s), bv1 = *(const bf16x8*)(b1 + s);
        c00 = __builtin_amdgcn_mfma_f32_16x16x32_bf16(bv0, av0, c00, 0, 0, 0); c01 = __builtin_amdgcn_mfma_f32_16x16x32_bf16(bv1, av0, c01, 0, 0, 0);
        c10 = __builtin_amdgcn_mfma_f32_16x16x32_bf16(bv0, av1, c10, 0, 0, 0); c11 = __builtin_amdgcn_mfma_f32_16x16x32_bf16(bv1, av1, c11, 0, 0, 0);
    }
    LAS float* w = red + wid * 1024 + fr * 32 + fq * 4;
    *(LAS f32x4*)(w) = c00; *(LAS f32x4*)(w + 16) = c01; *(LAS f32x4*)(w + 512) = c10; *(LAS f32x4*)(w + 528) = c11;
    __syncthreads();
    float2 r = make_float2(0.f, 0.f);
#pragma unroll
    for (int k = 0; k < 8; ++k) { const f32x2 v = *(const LAS f32x2*)(red + k * 1024 + tid * 2); r.x += v[0]; r.y += v[1]; }
    __syncthreads();
    return r;
}
#define SK_ROWCOL const int srow = tid >> 4, scol = (tid & 15) * 2

__device__ __forceinline__ void sphase_g1(unsigned char* ws, LAS float* red) {
    const int tid = opaque_tid(); SK_ROWCOL; unsigned char* sl = ws + WS_SLOT0; const bf16_t* win = (const bf16_t*)(ws + WS_WIN);
    for (int task = blockIdx.x; task < 640; task += gridDim.x) {
        const int seg = task >> 7, ct = (task & 127) >> 2, rt = task & 3;
        const bf16_t* A = (const bf16_t*)sl + (size_t)(TP + rt * 32) * D;
        float2 v; int so;
        if (seg != 3) { v = sk_tile(red, A, D, win + (size_t)((seg < 3 ? seg * 1024 : 5120) + ct * 32) * D, D, D, tid); so = seg < 3 ? 1 + seg : 5; }
        else { const float2 c = sk_tile(red, A, D, win + (size_t)(3072 + ct * 32) * D, D, D, tid), x = sk_tile(red, A, D, win + (size_t)(4096 + ct * 32) * D, D, D, tid); v = make_float2(c.x * x.x, c.y * x.y); so = 4; }
        *(unsigned*)((bf16_t*)(sl + (size_t)so * SLOT) + (size_t)(TP + rt * 32 + srow) * D + ct * 32 + scol) = cvt_pk_bf16(v.x, v.y);
    }
}
__device__ __forceinline__ void sphase_pool(unsigned char* ws, const float* pscale, LAS float* red) {
    const int tid = opaque_tid(); SK_ROWCOL; unsigned char* sl = ws + WS_SLOT0;
    for (int task = blockIdx.x; task < 128; task += gridDim.x) {
        const int g = task >> 5, ct = (task & 31) >> 2, rt = task & 3;
        const float2 v = sk_tile(red, (const bf16_t*)(sl + 2 * SLOT) + (size_t)(TP + rt * 32) * D + g * 256, D, (const bf16_t*)(ws + WS_WPOOL) + (size_t)g * 65536 + (size_t)ct * 32 * 256, 256, 256, tid);
        const int c = g * 256 + ct * 32 + scol;
        *(unsigned*)((bf16_t*)(ws + WS_SHC) + (size_t)(rt * 32 + srow) * D + c) = cvt_pk_bf16(v.x * pscale[c], v.y * pscale[c + 1]);
    }
}
__device__ __forceinline__ void sphase_gg(unsigned char* ws, LAS float* red) {
    const int tid = opaque_tid(); SK_ROWCOL; unsigned char* sl = ws + WS_SLOT0; const bf16_t* win = (const bf16_t*)(ws + WS_WIN);
    for (int task = blockIdx.x; task < 384; task += gridDim.x) {
        const int gi = task >> 7, ct = (task & 127) >> 2, rt = task & 3;
        const float2 v = sk_tile(red, (const bf16_t*)sl + (size_t)(TP + rt * 32) * D, D, win + (size_t)(6144 + gi * 1024 + ct * 32) * D, D, D, tid);
        *(unsigned*)((bf16_t*)(sl + (size_t)(4 + gi) * SLOT) + (size_t)(TP + rt * 32 + srow) * D + ct * 32 + scol) = cvt_pk_bf16(1.f / (1.f + __expf(-v.x)), 1.f / (1.f + __expf(-v.y)));
    }
}
__device__ __forceinline__ void sphase_p3(unsigned char* ws, LAS float* red) {
    const int tid = opaque_tid(); SK_ROWCOL; unsigned char* sl = ws + WS_SLOT0; const bf16_t* wp = (const bf16_t*)(ws + WS_WP);
    for (int task = blockIdx.x; task < 128; task += gridDim.x) {
        const int ct = task >> 2, rt = task & 3; float2 tot = make_float2(0.f, 0.f);
#pragma unroll 1
        for (int i = 0; i < 3; ++i) {
            const bf16_t* A = i == 0 ? (const bf16_t*)(sl + 1 * SLOT) + (size_t)(TP + rt * 32) * D : (i == 1 ? (const bf16_t*)(sl + 3 * SLOT) + (size_t)(TP + rt * 32) * D : (const bf16_t*)(ws + WS_SHC) + (size_t)(rt * 32) * D);
            const float2 v = sk_tile(red, A, D, wp + (size_t)(i * 1024 + ct * 32) * D, D, D, tid);
            const unsigned gg = *(const unsigned*)((const bf16_t*)(sl + (size_t)(4 + i) * SLOT) + (size_t)(TP + rt * 32 + srow) * D + ct * 32 + scol);
            tot.x += bflo(gg) * v.x; tot.y += bfhi(gg) * v.y;
        }
        *(unsigned*)((bf16_t*)sl + (size_t)(TP + rt * 32 + srow) * D + ct * 32 + scol) = cvt_pk_bf16(tot.x, tot.y);
    }
}
__device__ __forceinline__ void sphase_wo(unsigned char* ws, const float* xs, LAS float* red) {
    const int tid = opaque_tid(); SK_ROWCOL; unsigned char* sl = ws + WS_SLOT0;
    for (int task = blockIdx.x; task < 128; task += gridDim.x) {
        const int ct = task >> 2, rt = task & 3;
        const float2 v = sk_tile(red, (const bf16_t*)sl + (size_t)(TP + rt * 32) * D, D, (const bf16_t*)(ws + WS_WO) + (size_t)ct * 32 * D, D, D, tid);
        const int c = ct * 32 + scol; const float2 xv = *(const float2*)(xs + (size_t)(rt * 32 + srow) * D + c);
        *(float2*)((float*)(sl + 4 * SLOT) + (size_t)(TP + rt * 32 + srow) * D + c) = make_float2(ALPHA * xv.x + v.x, ALPHA * xv.y + v.y);
    }
}
__device__ __forceinline__ void sphase_ff1(unsigned char* ws, LAS float* red) {
    const int tid = opaque_tid(); SK_ROWCOL; unsigned char* sl = ws + WS_SLOT0;
    for (int task = blockIdx.x; task < 512; task += gridDim.x) {
        const int ct = task >> 2, rt = task & 3;
        const float2 v = sk_tile(red, (const bf16_t*)(sl + 6 * SLOT) + (size_t)(TP + rt * 32) * D, D, (const bf16_t*)(ws + WS_W1) + (size_t)ct * 32 * D, D, D, tid);
        const float a = fmaxf(v.x, 0.f), b = fmaxf(v.y, 0.f);
        *(unsigned*)((bf16_t*)sl + (size_t)(TP + rt * 32 + srow) * DFF + ct * 32 + scol) = cvt_pk_bf16(a * a, b * b);
    }
}
__device__ __forceinline__ void sphase_ff2(unsigned char* ws, const float* g, const float* b, LAS float* red) {
    const int tid = opaque_tid(); SK_ROWCOL; unsigned char* sl = ws + WS_SLOT0; const float* stats = (const float*)(ws + WS_STATS);
    for (int task = blockIdx.x; task < 128; task += gridDim.x) {
        const int ct = task >> 2, rt = task & 3;
        const float2 v = sk_tile(red, (const bf16_t*)sl + (size_t)(TP + rt * 32) * DFF, DFF, (const bf16_t*)(ws + WS_W2) + (size_t)ct * 32 * DFF, DFF, DFF, tid);
        const int row = TP + rt * 32 + srow, c = ct * 32 + scol; const float mu = stats[2 * row], rs = stats[2 * row + 1];
        float2* q = (float2*)((float*)(sl + 4 * SLOT) + (size_t)row * D + c); const float2 y = *q;
        *q = make_float2(ALPHA * ((y.x - mu) * rs * g[c] + b[c]) + v.x, ALPHA * ((y.y - mu) * rs * g[c + 1] + b[c + 1]) + v.y);
    }
}

__global__ void __launch_bounds__(512, 2) mega(Params p) {
    extern __shared__ __attribute__((aligned(16))) unsigned char shm[];
    LAS unsigned char* lds = (LAS unsigned char*)shm;
    cg::grid_group grid = cg::this_grid();
    for (int ph = p.ph0; ph < p.ph1; ++ph) {
        long z = 0; asm volatile("" : "+s"(z));
        unsigned char* ws = p.ws + z; unsigned char* sl = ws + WS_SLOT0;
        if (ph == 0) { phase_convert(p, z, 0, lds); phase_xb(p, z); }
        else {
            const int l = (ph - 1) / 11, k = (ph - 1) % 11;
            switch (k) {
            case 0: { SchedG1 S{(const char*)sl, (const char*)(ws + WS_WIN)}; EpiG1 E{sl}; gemm_phase(lds, S, E); } sphase_g1(ws, (LAS float*)lds); break;
            case 1: phase_e1(p, z, l, lds); break;
            case 2: phase_e2(p, z, l); break;
            case 3: { { SchedPool S{(const char*)(sl + 2 * SLOT), (const char*)(ws + WS_WPOOL)}; EpiPool E{sl, (p.pool_scale + z) + (size_t)l * D}; gemm_phase(lds, S, E); }
                      { SchedSpat S{(const char*)(ws + WS_WSBD), (const char*)(sl + 6 * SLOT)}; EpiSpat E{sl, (p.b_spatial + z) + (size_t)l * 4 * 128}; gemm_phase(lds, S, E); } } sphase_pool(ws, (p.pool_scale + z) + (size_t)l * D, (LAS float*)lds); break;
            case 4: { SchedGG S{(const char*)sl, (const char*)(ws + WS_WIN)}; EpiGG E{sl}; gemm_phase(lds, S, E); } sphase_gg(ws, (LAS float*)lds); break;
            case 5: { SchedP3 S{(const char*)sl, (const char*)(ws + WS_WP)}; EpiP3 E{sl}; gemm_phase(lds, S, E); } sphase_p3(ws, (LAS float*)lds); break;
            case 6: { SchedN4 S{(const char*)sl, (const char*)(ws + WS_WO)};
                      EpiWO E{(float*)(sl + 4 * SLOT), l == 0 ? (p.x_prompt + z) : (p.out + z), l == 0 ? (p.x_sample + z) : (p.out + z) + (size_t)TP * D}; gemm_phase(lds, S, E); } sphase_wo(ws, l == 0 ? (p.x_sample + z) : (p.out + z) + (size_t)TP * D, (LAS float*)lds); break;
            case 7: phase_ln((const float*)(sl + 4 * SLOT), (p.ln1_g + z) + l * D, (p.ln1_b + z) + l * D, (bf16_t*)(sl + 6 * SLOT), (float*)(ws + WS_STATS), nullptr); break;
            case 8: { SchedFF1 S{(const char*)(sl + 6 * SLOT), (const char*)(ws + WS_W1)}; EpiFF1 E{(bf16_t*)sl}; gemm_phase(lds, S, E); } sphase_ff1(ws, (LAS float*)lds); break;
            case 9: { SchedFF2 S{(const char*)sl, (const char*)(ws + WS_W2)};
                      EpiFF2 E{(float*)(sl + 4 * SLOT), (const float*)(ws + WS_STATS), (p.ln1_g + z) + l * D, (p.ln1_b + z) + l * D}; gemm_phase(lds, S, E); } sphase_ff2(ws, (p.ln1_g + z) + l * D, (p.ln1_b + z) + l * D, (LAS float*)lds); break;
            case 10: phase_ln((const float*)(sl + 4 * SLOT), (p.ln2_g + z) + l * D, (p.ln2_b + z) + l * D, (bf16_t*)sl, nullptr, (p.out + z));
                     if (l == 0) phase_convert(p, z, 1, lds); break;
            }
        }
        if (ph + 1 < p.ph1) grid.sync();
    }
}

extern "C" void kernel_launch(void* const* d_in, const int* in_sizes, int n_in, void* d_out, int out_size, void* d_ws, size_t ws_size, hipStream_t stream) {
    static int grid = 0;
    if (grid == 0) {
        if (n_in != 23 || ws_size < WS_END) { fprintf(stderr, "kernel_launch: need 23 inputs and >= %zu bytes of workspace; got %d, %zu\n", (size_t)WS_END, n_in, ws_size); grid = -1; return; }
        int dev = 0, cus = 0, per_cu = 0;
        hipGetDevice(&dev); hipDeviceGetAttribute(&cus, hipDeviceAttributeMultiprocessorCount, dev);
        if (hipFuncSetAttribute((const void*)mega, hipFuncAttributeMaxDynamicSharedMemorySize, STAGE_BYTES) != hipSuccess) { fprintf(stderr, "kernel_launch: hipFuncSetAttribute failed\n"); grid = -1; return; }
        if (hipOccupancyMaxActiveBlocksPerMultiprocessor(&per_cu, (const void*)mega, 512, STAGE_BYTES) != hipSuccess || per_cu < 1) { fprintf(stderr, "kernel_launch: occupancy query failed (%d)\n", per_cu); grid = -1; return; }
        grid = cus;
    }
    if (grid < 0) return;
    Params p{};
    const float** pp = (const float**)&p;
    for (int i = 0; i < 23; ++i) pp[i] = (const float*)d_in[i];
    p.out = (float*)d_out; p.ws = (unsigned char*)d_ws; p.ph0 = 0; p.ph1 = 23;
    void* args[] = {&p};
    hipError_t e = hipLaunchCooperativeKernel((const void*)mega, dim3(grid), dim3(512), args, STAGE_BYTES, stream);
    if (e != hipSuccess) fprintf(stderr, "cooperative launch failed: %s (grid %d)\n", hipGetErrorString(e), grid);
}
```

```cpp
#include <hip/hip_runtime.h>
#include <hip/hip_cooperative_groups.h>
#include <cstdio>
namespace cg = cooperative_groups;

#define LAS __attribute__((address_space(3)))
typedef unsigned short bf16_t;
typedef short bf16x8 __attribute__((ext_vector_type(8)));
typedef float f32x4 __attribute__((ext_vector_type(4)));
typedef float f32x2 __attribute__((ext_vector_type(2)));

constexpr int D = 1024, TP = 16384, TS = 128, TV = TP + TS, T = 16640, NMT = TP / 256;
constexpr int DIN = 9216, DFF = 4096, SEQ = 2048;
constexpr float ALPHA = 1.4142135623730951f;
constexpr float LN_EPS = 1e-5f;
constexpr int BM = 256, BK = 64, HALF = 128, HTB = HALF * BK * 2, STAGE_BYTES = 8 * HTB;

constexpr size_t SLOT = (size_t)T * D * 2;
constexpr size_t WS_WIN = 0;
constexpr size_t WS_WP = WS_WIN + (size_t)DIN * D * 2;
constexpr size_t WS_WO = WS_WP + 3ull * D * D * 2;
constexpr size_t WS_W1 = WS_WO + (size_t)D * D * 2;
constexpr size_t WS_W2 = WS_W1 + (size_t)DFF * D * 2;
constexpr size_t WS_WPOOL = WS_W2 + (size_t)DFF * D * 2;
constexpr size_t WS_WSBD = WS_WPOOL + 4ull * 256 * 256 * 2;
constexpr size_t WS_SHC = WS_WSBD + 4ull * 256 * 256 * 2;
constexpr size_t WS_STATS = WS_SHC + (size_t)TS * D * 2;
constexpr size_t WS_SLOT0 = WS_STATS + (size_t)T * 8;
constexpr size_t WS_BAR = WS_SLOT0 + 7 * SLOT;
constexpr size_t WS_END = WS_BAR + 16384;
constexpr int LDS_BYTES = STAGE_BYTES + 16;

constexpr size_t O_Y = 0;
constexpr size_t O_CONVP = (size_t)TV * D;
constexpr size_t O_POOLP = O_CONVP + 2ull * 8 * 2 * D;
constexpr size_t O_CONVS = O_POOLP + 2ull * 8 * 15 * D;
constexpr size_t O_POOLS = O_CONVS + 2ull * 128 * 2 * D;
constexpr size_t O_CHV = O_POOLS + 2ull * 128 * 15 * D;

struct Params {
    const float *x_prompt, *x_sample, *state_conv, *state_pool, *w_in, *lnv_g, *lnv_b, *w_spatial, *b_spatial, *w_proj_a, *conv_w, *conv_b, *w_proj_b,
        *w_pool, *pool_scale, *w_proj_c, *w_o, *ln1_g, *ln1_b, *w_ff1, *w_ff2, *ln2_g, *ln2_b;
    float* out;
    unsigned char* ws;
    int ph0, ph1;
};

__device__ __forceinline__ unsigned short f2bf(float f) { unsigned u = __float_as_uint(f); u += 0x7FFFu + ((u >> 16) & 1u); return (unsigned short)(u >> 16); }
__device__ __forceinline__ unsigned cvt_pk_bf16(float lo, float hi) { unsigned r; asm volatile("v_cvt_pk_bf16_f32 %0, %1, %2" : "=v"(r) : "v"(lo), "v"(hi)); return r; }
__device__ __forceinline__ float bflo(unsigned u) { return __uint_as_float(u << 16); }
__device__ __forceinline__ float bfhi(unsigned u) { return __uint_as_float(u & 0xffff0000u); }
__device__ __forceinline__ uint4 pack8(const f32x4 a, const f32x4 b) { return make_uint4(cvt_pk_bf16(a[0], a[1]), cvt_pk_bf16(a[2], a[3]), cvt_pk_bf16(b[0], b[1]), cvt_pk_bf16(b[2], b[3])); }
__device__ __forceinline__ void unpack8(const uint4 u, f32x4& a, f32x4& b) { a[0] = bflo(u.x); a[1] = bfhi(u.x); a[2] = bflo(u.y); a[3] = bfhi(u.y); b[0] = bflo(u.z); b[1] = bfhi(u.z); b[2] = bflo(u.w); b[3] = bfhi(u.w); }
__device__ __forceinline__ float wave_sum(float v) {
#pragma unroll
    for (int m = 32; m >= 1; m >>= 1) v += __shfl_xor(v, m);
    return v;
}

__device__ __forceinline__ int lds_byte(int r, int c) { const int st = (r >> 4) * 2 + (c >> 5), rr = r & 15, cc = c & 31, ob = rr * 64 + cc * 2; return st * 1024 + (ob ^ (((ob >> 9) & 1) << 5)); }
__device__ __forceinline__ void stage_rc(int b, int& R, int& C) { const int st = b / 1024, sb = b % 1024, swz = sb ^ (((sb >> 9) & 1) << 5); R = (st >> 1) * 16 + swz / 64; C = (st & 1) * 32 + (swz % 64) / 2; }
__device__ __forceinline__ int perm32(int rho) { const int n = rho >> 4, i = rho & 15; return 8 * (i >> 2) + 4 * n + (i & 3); }

__device__ __forceinline__ const char* uni_ptr(const char* p) { unsigned long long v = (unsigned long long)p; unsigned lo = __builtin_amdgcn_readfirstlane((unsigned)v), hi = __builtin_amdgcn_readfirstlane((unsigned)(v >> 32)); asm volatile("" : "+s"(lo), "+s"(hi)); return (const char*)(((unsigned long long)hi << 32) | lo); }
__device__ __forceinline__ int opaque_tid() { int t = threadIdx.x; asm volatile("" : "+v"(t)); return t; }
struct Unit { const char* A; const char* B; unsigned ahs, bhs; int pm, pn, aux; };

__device__ __forceinline__ bool tile_order(int i, int nM, int nN, int& pm, int& pn) {
    int c = blockIdx.x; asm volatile("" : "+s"(c));
    const int G = gridDim.x, nwg = nM * nN;
    const long L = (long)i * G + c; if (L >= nwg) return false;
    int wgid = (int)L; { const int q = nwg / 8, r = nwg % 8, xcd = wgid % 8, off = wgid / 8; wgid = (xcd < r ? xcd * (q + 1) : r * (q + 1) + (xcd - r) * q) + off; }
    const int nig = 8 * nN, gid = wgid / nig, fm = gid * 8, gsz = (nM - fm) < 8 ? (nM - fm) : 8;
    pm = fm + ((wgid % nig) % gsz); pn = (wgid % nig) / gsz; return true;
}

template <class Sched, class Epi>
__device__ __forceinline__ void gemm_phase(LAS unsigned char* lds, const Sched& S, const Epi& E) {
    int tid = threadIdx.x; asm volatile("" : "+v"(tid));
    const int wid = __builtin_amdgcn_readfirstlane(tid >> 6), lane = tid & 63, wr = wid >> 2, wc = wid & 3, fr = lane & 15, fq = lane >> 4;
    constexpr int nt = Sched::NT;
    unsigned vA[2], vB[2];
#pragma unroll
    for (int i = 0; i < 2; ++i) { int R, C; stage_rc(tid * 16 + i * 8192, R, C); vA[i] = (unsigned)R * Sched::LDA2 + (unsigned)(C * 2); vB[i] = (unsigned)((R & ~31) + perm32(R & 31)) * Sched::LDB2 + (unsigned)(C * 2); }
    const size_t kstep = (size_t)(BK * 2);
    const unsigned ldsw = (unsigned)wid * 1024u;
    const int aoff = lds_byte(wr * 64 + fr, fq * 8), boff = lds_byte(wc * 32 + fr, fq * 8);
#define SA_(b, h) (((b) * 2 + (h)) * HTB)
#define SB_(b, h) ((4 + (b) * 2 + (h)) * HTB)
#define STAGE_(bufoff, gbase, voff) do { _Pragma("unroll") for (int _i = 0; _i < 2; ++_i) \
        __builtin_amdgcn_global_load_lds((const unsigned*)((const char*)(gbase) + (voff)[_i]), (LAS unsigned*)(lds + (bufoff) + ldsw + _i * 8192), 16, 0, 0); } while (0)
#define LDA_(dst, b, h) do { _Pragma("unroll") for (int m = 0; m < 4; ++m) _Pragma("unroll") for (int k = 0; k < 2; ++k) dst[m][k] = *(const LAS bf16x8*)(lds + SA_(b, h) + aoff + m * 2048 + k * 1024); } while (0)
#define LDB_(dst, b, h) do { _Pragma("unroll") for (int n = 0; n < 2; ++n) _Pragma("unroll") for (int k = 0; k < 2; ++k) dst[n][k] = *(const LAS bf16x8*)(lds + SB_(b, h) + boff + n * 2048 + k * 1024); } while (0)
#define MMA_(ai, bj, At, Bt) do { __builtin_amdgcn_s_setprio(1); _Pragma("unroll") for (int m = 0; m < 4; ++m) _Pragma("unroll") for (int n = 0; n < 2; ++n) _Pragma("unroll") for (int k = 0; k < 2; ++k) \
        acc[ai][bj][m][n] = __builtin_amdgcn_mfma_f32_16x16x32_bf16(Bt[n][k], At[m][k], acc[ai][bj][m][n], 0, 0, 0); __builtin_amdgcn_s_setprio(0); } while (0)
#define WAIT_V_(n) asm volatile("s_waitcnt vmcnt(" #n ")" ::: "memory")
#define WAIT_L_(n) asm volatile("s_waitcnt lgkmcnt(" #n ")" ::: "memory")
#define BAR_ __builtin_amdgcn_s_barrier()
#define SCHED_ __builtin_amdgcn_sched_barrier(0)
    Unit cur, nxt; int ui = 0;
    if (!S.next(0, cur)) return;
    cur.A = uni_ptr(cur.A); cur.B = uni_ptr(cur.B);
    f32x4 acc[2][2][4][2];
#pragma unroll
    for (int a = 0; a < 2; ++a)
#pragma unroll
        for (int b = 0; b < 2; ++b)
#pragma unroll
            for (int m = 0; m < 4; ++m)
#pragma unroll
                for (int n = 0; n < 2; ++n) acc[a][b][m][n] = (f32x4){0.f, 0.f, 0.f, 0.f};
    bf16x8 At[4][2], B0[2][2], B1[2][2];
    const char* cA = cur.A; const char* cB = cur.B;
    STAGE_(SB_(0, 0), cB, vB); STAGE_(SA_(0, 0), cA, vA); STAGE_(SB_(0, 1), cB + cur.bhs, vB); STAGE_(SA_(0, 1), cA + cur.ahs, vA);
    if (wr == 1) BAR_;
    WAIT_V_(4); BAR_;
    STAGE_(SB_(1, 0), cB + kstep, vB); STAGE_(SA_(1, 0), cA + kstep, vA); STAGE_(SB_(1, 1), cB + cur.bhs + kstep, vB);
    WAIT_V_(6); BAR_;
    for (;;) {
        const bool has_next = S.next(ui + 1, nxt);
        if (!has_next) nxt = cur;
        nxt.A = uni_ptr(nxt.A); nxt.B = uni_ptr(nxt.B);
        const char* nA = nxt.A; const char* nB = nxt.B;
#pragma unroll 1
        for (int t = 0; t < nt; t += 2) {
            const bool last = (t == nt - 2);
            const char* a1 = cA + (size_t)(t + 1) * kstep;
            const char* a2 = last ? nA : cA + (size_t)(t + 2) * kstep; const char* b2 = last ? nB : cB + (size_t)(t + 2) * kstep;
            const char* a3 = a2 + kstep; const char* b3 = b2 + kstep;
            const unsigned ahs2 = last ? nxt.ahs : cur.ahs, bhs2 = last ? nxt.bhs : cur.bhs;
            LDB_(B0, 0, 0); SCHED_; LDA_(At, 0, 0); STAGE_(SA_(1, 1), a1 + cur.ahs, vA);
            WAIT_L_(8); BAR_; WAIT_L_(0); MMA_(0, 0, At, B0); BAR_; SCHED_;
            LDB_(B1, 0, 1); STAGE_(SB_(0, 0), b2, vB);
            BAR_; WAIT_L_(0); MMA_(0, 1, At, B1); BAR_;
            LDA_(At, 0, 1); STAGE_(SA_(0, 0), a2, vA);
            BAR_; WAIT_L_(0); MMA_(1, 0, At, B0); BAR_; SCHED_;
            STAGE_(SB_(0, 1), b2 + bhs2, vB);
            WAIT_V_(6); BAR_; MMA_(1, 1, At, B1); BAR_;
            LDB_(B0, 1, 0); SCHED_; LDA_(At, 1, 0); STAGE_(SA_(0, 1), a2 + ahs2, vA);
            WAIT_L_(8); BAR_; WAIT_L_(0); MMA_(0, 0, At, B0); BAR_; SCHED_;
            LDB_(B1, 1, 1); STAGE_(SB_(1, 0), b3, vB);
            BAR_; WAIT_L_(0); MMA_(0, 1, At, B1); BAR_;
            LDA_(At, 1, 1); STAGE_(SA_(1, 0), a3, vA);
            BAR_; WAIT_L_(0); MMA_(1, 0, At, B0); BAR_; SCHED_;
            STAGE_(SB_(1, 1), b3 + bhs2, vB);
            WAIT_V_(6); BAR_; MMA_(1, 1, At, B1); BAR_;
        }
        int fr2 = fr, fq2 = fq; asm volatile("" : "+v"(fr2), "+v"(fq2));
        const bool fin = E.finish(acc, cur, wr, wc, fr2, fq2);
        if (!has_next) break;
        if (fin) {
#pragma unroll
            for (int a = 0; a < 2; ++a)
#pragma unroll
                for (int b = 0; b < 2; ++b)
#pragma unroll
                    for (int m = 0; m < 4; ++m)
#pragma unroll
                        for (int n = 0; n < 2; ++n) acc[a][b][m][n] = (f32x4){0.f, 0.f, 0.f, 0.f};
        }
        cur = nxt; cA = nA; cB = nB; ++ui;
    }
    WAIT_V_(0);
    if (wr == 0) BAR_;
    BAR_;
#undef SA_
#undef SB_
#undef STAGE_
#undef LDA_
#undef LDB_
#undef MMA_
#undef WAIT_V_
#undef WAIT_L_
#undef BAR_
#undef SCHED_
}

#define ACC_T f32x4 (&acc)[2][2][4][2]
#define ROW_(u, ai, m) ((u).pm * 256 + (ai) * 128 + wr * 64 + (m) * 16 + fr)

struct SchedG1 {
    static constexpr int NT = 16; static constexpr unsigned LDA2 = 2048, LDB2 = 2048; const char *xb, *win;
    __device__ __forceinline__ bool next(int i, Unit& u) const {
        int pm, pn; if (!tile_order(i, NMT, 24, pm, pn)) return false;
        u.pm = pm; u.pn = pn; u.aux = 0; u.A = xb + (size_t)pm * 256 * 2048; u.ahs = 128 * 2048;
        if (pn < 12) { u.B = win + (size_t)pn * 256 * 2048; u.bhs = 128 * 2048; }
        else if (pn < 20) { u.B = win + (size_t)(3072 + 128 * (pn - 12)) * 2048; u.bhs = 1024 * 2048; }
        else { u.B = win + (size_t)(5120 + 256 * (pn - 20)) * 2048; u.bhs = 128 * 2048; }
        return true;
    }
};
struct EpiG1 {
    unsigned char* slots;
    __device__ __forceinline__ bool finish(ACC_T, const Unit& u, int wr, int wc, int fr, int fq) const {
        const int ct = u.pn;
        if (ct >= 12 && ct < 20) {
            bf16_t* o = (bf16_t*)(slots + 4 * SLOT) + 128 * (ct - 12) + wc * 32 + 8 * fq;
#pragma unroll
            for (int ai = 0; ai < 2; ++ai)
#pragma unroll
                for (int m = 0; m < 4; ++m) { const size_t row = ROW_(u, ai, m);
                    *(uint4*)(o + row * D) = pack8(acc[ai][0][m][0] * acc[ai][1][m][0], acc[ai][0][m][1] * acc[ai][1][m][1]); }
        } else {
            const int sl = ct < 12 ? 1 + (ct >> 2) : 5, ctile = ct < 12 ? (ct & 3) : ct - 20;
            bf16_t* o = (bf16_t*)(slots + (size_t)sl * SLOT) + ctile * 256 + wc * 32 + 8 * fq;
#pragma unroll
            for (int ai = 0; ai < 2; ++ai)
#pragma unroll
                for (int m = 0; m < 4; ++m) { const size_t row = ROW_(u, ai, m);
#pragma unroll
                    for (int bj = 0; bj < 2; ++bj) *(uint4*)(o + row * D + bj * 128) = pack8(acc[ai][bj][m][0], acc[ai][bj][m][1]); }
        }
        return true;
    }
};

struct SchedSpat {
    static constexpr int NT = 4; static constexpr unsigned LDA2 = 512, LDB2 = T * 2; const char *wsbd, *vnT;
    __device__ __forceinline__ bool next(int i, Unit& u) const {
        int c = blockIdx.x; asm volatile("" : "+s"(c)); const long L = (long)i * gridDim.x + c; if (L >= NMT * 4) return false;
        const int pm = (int)L >> 2, g = (int)L & 3; u.pm = pm; u.pn = g; u.aux = 0;
        u.A = wsbd + (size_t)g * 256 * 512; u.ahs = 128 * 512;
        u.B = vnT + ((size_t)g * 256 * T + (size_t)pm * 256) * 2; u.bhs = 128u * T * 2; return true;
    }
};
struct SchedPool {
    static constexpr int NT = 4; static constexpr unsigned LDA2 = 2048, LDB2 = 512; const char *dbuf, *wpoolT;
    __device__ __forceinline__ bool next(int i, Unit& u) const {
        int c = blockIdx.x; asm volatile("" : "+s"(c)); const long L = (long)i * gridDim.x + c; if (L >= NMT * 4) return false;
        const int pm = (int)L >> 2, g = (int)L & 3; u.pm = pm; u.pn = g; u.aux = 1;
        u.A = dbuf + ((size_t)pm * 256 * D + g * 256) * 2; u.ahs = 128 * 2048;
        u.B = wpoolT + (size_t)g * 256 * 512; u.bhs = 128 * 512; return true;
    }
};
struct EpiSpat {
    unsigned char* slots; const float* bsp; long wofs;
    __device__ __forceinline__ bool finish(ACC_T, const Unit& u, int wr, int wc, int fr, int fq) const {
        const int g = u.pn;
        bf16_t* o = (bf16_t*)(slots + 1 * SLOT) + g * 256 + wc * 32 + 8 * fq;
        uint4 ub[3][2]; float bsb[3];
        auto LOAD = [&](int gi, int sl_) { const int row = ROW_(u, gi >> 2, gi & 3); bsb[sl_] = bsp[g * 128 + (row & 127)];
            ub[sl_][0] = *(const uint4*)(o + (size_t)row * D); ub[sl_][1] = *(const uint4*)(o + (size_t)row * D + 128); };
        auto STORE = [&](int gi, int sl_) { const int ai = gi >> 2, m = gi & 3; const int row = ROW_(u, ai, m); const float bs = bsb[sl_];
#pragma unroll
            for (int bj = 0; bj < 2; ++bj) { f32x4 u0, u1; unpack8(ub[sl_][bj], u0, u1);
                *(uint4*)((char*)(o + (size_t)row * D + bj * 128) + wofs) = pack8(u0 * (acc[ai][bj][m][0] + bs), u1 * (acc[ai][bj][m][1] + bs)); } };
        LOAD(0, 0); LOAD(1, 1);
#pragma unroll
        for (int gi = 0; gi < 8; ++gi) { if (gi + 2 < 8) LOAD(gi + 2, (gi + 2) % 3); STORE(gi, gi % 3); __builtin_amdgcn_sched_barrier(0); }
        return true;
    }
};
struct EpiPool {
    unsigned char* slots; const float* pscale; long wofs;
    __device__ __forceinline__ bool finish(ACC_T, const Unit& u, int wr, int wc, int fr, int fq) const {
        const int g = u.pn;
        bf16_t* o = (bf16_t*)(slots + 2 * SLOT) + g * 256 + wc * 32 + 8 * fq;
        f32x4 sc[2][2];
#pragma unroll
        for (int bj = 0; bj < 2; ++bj)
#pragma unroll
            for (int n = 0; n < 2; ++n) sc[bj][n] = *(const f32x4*)(pscale + g * 256 + bj * 128 + wc * 32 + 8 * fq + 4 * n);
#pragma unroll
        for (int ai = 0; ai < 2; ++ai)
#pragma unroll
            for (int m = 0; m < 4; ++m) { const size_t row = ROW_(u, ai, m);
#pragma unroll
                for (int bj = 0; bj < 2; ++bj) *(uint4*)((char*)(o + row * D + bj * 128) + wofs) = pack8(acc[ai][bj][m][0] * sc[bj][0], acc[ai][bj][m][1] * sc[bj][1]); }
        return true;
    }
};

struct SchedGG {
    static constexpr int NT = 16; static constexpr unsigned LDA2 = 2048, LDB2 = 2048; const char *xb, *win;
    __device__ __forceinline__ bool next(int i, Unit& u) const {
        int pm, pn; if (!tile_order(i, NMT, 12, pm, pn)) return false;
        u.pm = pm; u.pn = pn; u.aux = 0; u.A = xb + (size_t)pm * 256 * 2048; u.ahs = 128 * 2048;
        u.B = win + (size_t)(6144 + 256 * pn) * 2048; u.bhs = 128 * 2048; return true;
    }
};
struct EpiGG {
    unsigned char* slots;
    __device__ __forceinline__ bool finish(ACC_T, const Unit& u, int wr, int wc, int fr, int fq) const {
        bf16_t* o = (bf16_t*)(slots + (size_t)(4 + (u.pn >> 2)) * SLOT) + (u.pn & 3) * 256 + wc * 32 + 8 * fq;
#pragma unroll
        for (int ai = 0; ai < 2; ++ai)
#pragma unroll
            for (int m = 0; m < 4; ++m) { const size_t row = ROW_(u, ai, m);
#pragma unroll
                for (int bj = 0; bj < 2; ++bj) { f32x4 s0, s1;
#pragma unroll
                    for (int k = 0; k < 4; ++k) { s0[k] = 1.f / (1.f + __expf(-acc[ai][bj][m][0][k])); s1[k] = 1.f / (1.f + __expf(-acc[ai][bj][m][1][k])); }
                    *(uint4*)(o + row * D + bj * 128) = pack8(s0, s1); } }
        return true;
    }
};

struct SchedP3 {
    static constexpr int NT = 16; static constexpr unsigned LDA2 = 2048, LDB2 = 2048; const char *slots, *wp;
    __device__ __forceinline__ bool next(int i, Unit& u) const {
        const int un = i / 3, seg = i - un * 3; int pm, pn; if (!tile_order(un, NMT, 4, pm, pn)) return false;
        u.pm = pm; u.pn = pn; u.aux = seg; const int sl = seg == 0 ? 1 : (seg == 1 ? 3 : 2);
        u.A = slots + (size_t)sl * SLOT + (size_t)pm * 256 * 2048; u.ahs = 128 * 2048;
        u.B = wp + ((size_t)seg * 1024 + pn * 256) * 2048; u.bhs = 128 * 2048; return true;
    }
};
struct EpiP3 {
    unsigned char* slots;
    __device__ __forceinline__ bool finish(ACC_T, const Unit& u, int wr, int wc, int fr, int fq) const {
        const int seg = u.aux; const size_t cofs = (size_t)u.pn * 256 + wc * 32 + 8 * fq;
        const bf16_t* ga = (const bf16_t*)(slots + (size_t)(4 + seg) * SLOT) + cofs;
        bf16_t* o = (bf16_t*)(slots) + cofs;
        uint4 gb[3][2], pb[3][2];
        auto LOAD = [&](int gi, int sl_) { const size_t row = ROW_(u, gi >> 2, gi & 3);
            gb[sl_][0] = *(const uint4*)(ga + row * D); gb[sl_][1] = *(const uint4*)(ga + row * D + 128);
            if (seg > 0) { pb[sl_][0] = *(const uint4*)(o + row * D); pb[sl_][1] = *(const uint4*)(o + row * D + 128); } };
        auto STORE = [&](int gi, int sl_) { const int ai = gi >> 2, m = gi & 3; const size_t row = ROW_(u, ai, m);
#pragma unroll
            for (int bj = 0; bj < 2; ++bj) { f32x4 a0, a1; unpack8(gb[sl_][bj], a0, a1);
                f32x4 v0 = acc[ai][bj][m][0] * a0, v1 = acc[ai][bj][m][1] * a1;
                if (seg > 0) { f32x4 p0, p1; unpack8(pb[sl_][bj], p0, p1); v0 += p0; v1 += p1; }
                *(uint4*)(o + row * D + bj * 128) = pack8(v0, v1); } };
        LOAD(0, 0); LOAD(1, 1);
#pragma unroll
        for (int gi = 0; gi < 8; ++gi) { if (gi + 2 < 8) LOAD(gi + 2, (gi + 2) % 3); STORE(gi, gi % 3); __builtin_amdgcn_sched_barrier(0); }
        return true;
    }
};

struct SchedN4 {
    static constexpr int NT = 16; static constexpr unsigned LDA2 = 2048, LDB2 = 2048; const char *A, *B;
    __device__ __forceinline__ bool next(int i, Unit& u) const {
        int pm, pn; if (!tile_order(i, NMT, 4, pm, pn)) return false;
        u.pm = pm; u.pn = pn; u.aux = 0; u.A = A + (size_t)pm * 256 * 2048; u.ahs = 128 * 2048; u.B = B + (size_t)pn * 256 * 2048; u.bhs = 128 * 2048; return true;
    }
};
struct EpiWO {
    float* y1; const float* xa;
    __device__ __forceinline__ bool finish(ACC_T, const Unit& u, int wr, int wc, int fr, int fq) const {
        const int c0 = u.pn * 256 + wc * 32 + 8 * fq;
        f32x4 xb[3][4];
        auto LOAD = [&](int gi, int sl_) { const float* xr = xa + (size_t)ROW_(u, gi >> 2, gi & 3) * D + c0;
            xb[sl_][0] = *(const f32x4*)(xr); xb[sl_][1] = *(const f32x4*)(xr + 4); xb[sl_][2] = *(const f32x4*)(xr + 128); xb[sl_][3] = *(const f32x4*)(xr + 132); };
        auto STORE = [&](int gi, int sl_) { const int ai = gi >> 2, m = gi & 3; float* q = y1 + (size_t)ROW_(u, ai, m) * D + c0;
            *(f32x4*)(q) = xb[sl_][0] * ALPHA + acc[ai][0][m][0]; *(f32x4*)(q + 4) = xb[sl_][1] * ALPHA + acc[ai][0][m][1];
            *(f32x4*)(q + 128) = xb[sl_][2] * ALPHA + acc[ai][1][m][0]; *(f32x4*)(q + 132) = xb[sl_][3] * ALPHA + acc[ai][1][m][1]; };
        LOAD(0, 0); LOAD(1, 1);
#pragma unroll
        for (int gi = 0; gi < 8; ++gi) { if (gi + 2 < 8) LOAD(gi + 2, (gi + 2) % 3); STORE(gi, gi % 3); __builtin_amdgcn_sched_barrier(0); }
        return true;
    }
};

struct SchedFF1 {
    static constexpr int NT = 16; static constexpr unsigned LDA2 = 2048, LDB2 = 2048; const char *A, *B;
    __device__ __forceinline__ bool next(int i, Unit& u) const {
        int pm, pn; if (!tile_order(i, NMT, 16, pm, pn)) return false;
        u.pm = pm; u.pn = pn; u.aux = 0; u.A = A + (size_t)pm * 256 * 2048; u.ahs = 128 * 2048; u.B = B + (size_t)pn * 256 * 2048; u.bhs = 128 * 2048; return true;
    }
};
struct EpiFF1 {
    bf16_t* f1;
    __device__ __forceinline__ bool finish(ACC_T, const Unit& u, int wr, int wc, int fr, int fq) const {
        bf16_t* o = f1 + u.pn * 256 + wc * 32 + 8 * fq;
#pragma unroll
        for (int ai = 0; ai < 2; ++ai)
#pragma unroll
            for (int m = 0; m < 4; ++m) { const size_t row = ROW_(u, ai, m);
#pragma unroll
                for (int bj = 0; bj < 2; ++bj) { f32x4 s0, s1;
#pragma unroll
                    for (int k = 0; k < 4; ++k) { const float a = fmaxf(acc[ai][bj][m][0][k], 0.f), b = fmaxf(acc[ai][bj][m][1][k], 0.f); s0[k] = a * a; s1[k] = b * b; }
                    *(uint4*)(o + row * DFF + bj * 128) = pack8(s0, s1); } }
        return true;
    }
};

struct SchedFF2 {
    static constexpr int NT = 64; static constexpr unsigned LDA2 = 8192, LDB2 = 8192; const char *A, *B;
    __device__ __forceinline__ bool next(int i, Unit& u) const {
        int pm, pn; if (!tile_order(i, NMT, 4, pm, pn)) return false;
        u.pm = pm; u.pn = pn; u.aux = 0; u.A = A + (size_t)pm * 256 * 8192; u.ahs = 128 * 8192; u.B = B + (size_t)pn * 256 * 8192; u.bhs = 128 * 8192; return true;
    }
};
struct EpiFF2 {
    float* y1; const float* stats; const float *g, *b; long wofs;
    __device__ __forceinline__ bool finish(ACC_T, const Unit& u, int wr, int wc, int fr, int fq) const {
        const int c0 = u.pn * 256 + wc * 32 + 8 * fq;
        f32x4 gv[4], bv[4];
#pragma unroll
        for (int j = 0; j < 4; ++j) { const int c = c0 + (j >> 1) * 128 + (j & 1) * 4; gv[j] = *(const f32x4*)(g + c); bv[j] = *(const f32x4*)(b + c); }
        f32x4 yb[3][4]; f32x2 sb[3];
        auto LOAD = [&](int gi, int sl_) { const int row = ROW_(u, gi >> 2, gi & 3); const float* q = y1 + (size_t)row * D + c0; sb[sl_] = *(const f32x2*)(stats + 2 * row);
            yb[sl_][0] = *(const f32x4*)(q); yb[sl_][1] = *(const f32x4*)(q + 4); yb[sl_][2] = *(const f32x4*)(q + 128); yb[sl_][3] = *(const f32x4*)(q + 132); };
        auto STORE = [&](int gi, int sl_) { const int ai = gi >> 2, m = gi & 3; char* q = (char*)(y1 + (size_t)ROW_(u, ai, m) * D + c0) + wofs; const float mu = sb[sl_][0], rs = sb[sl_][1];
#pragma unroll
            for (int j = 0; j < 4; ++j) { const f32x4 h = (yb[sl_][j] - mu) * rs * gv[j] + bv[j]; *(f32x4*)(q + ((j >> 1) * 128 + (j & 1) * 4) * 4) = h * ALPHA + acc[ai][j >> 1][m][j & 1]; } };
        LOAD(0, 0); LOAD(1, 1);
#pragma unroll
        for (int gi = 0; gi < 8; ++gi) { if (gi + 2 < 8) LOAD(gi + 2, (gi + 2) % 3); STORE(gi, gi % 3); __builtin_amdgcn_sched_barrier(0); }
        return true;
    }
};

__device__ __forceinline__ void conv_tile(const float* __restrict__ src, int N, bf16_t* __restrict__ dst, int K, int k0, int n0, LAS unsigned short* tile) {
    const int tid = opaque_tid();
    float4 v[8];
#pragma unroll
    for (int i = 0; i < 8; ++i) v[i] = *(const float4*)(src + (size_t)(k0 + (tid >> 6) + 8 * i) * N + n0 + (tid & 63) * 4);
#pragma unroll
    for (int i = 0; i < 8; ++i) { const int k = (tid >> 6) + 8 * i, n4 = (tid & 63) * 4;
        tile[(n4 + 0) * 66 + k] = f2bf(v[i].x); tile[(n4 + 1) * 66 + k] = f2bf(v[i].y); tile[(n4 + 2) * 66 + k] = f2bf(v[i].z); tile[(n4 + 3) * 66 + k] = f2bf(v[i].w); }
    __syncthreads();
    { const int n = tid >> 1, k32 = (tid & 1) * 32; const LAS unsigned* sp = (const LAS unsigned*)(tile + n * 66 + k32); uint4* o = (uint4*)(dst + (size_t)(n0 + n) * K + k0 + k32);
#pragma unroll
        for (int j = 0; j < 4; ++j) o[j] = make_uint4(sp[4 * j], sp[4 * j + 1], sp[4 * j + 2], sp[4 * j + 3]); }
    __syncthreads();
}

__device__ __forceinline__ void phase_convert(const Params& p, long z, int l, LAS unsigned char* lds) {
    unsigned char* ws = (p.ws + z); LAS unsigned short* tile = (LAS unsigned short*)lds;
    for (int t = blockIdx.x; t < 1360; t += gridDim.x) {
        const float* src; bf16_t* dst; int K, N, tt;
        if (t < 576) { tt = t; src = (p.w_in + z) + (size_t)l * D * DIN; K = D; N = DIN; dst = (bf16_t*)(ws + WS_WIN); }
        else if (t < 768) { const int i = (t - 576) >> 6; tt = (t - 576) & 63; src = (i == 0 ? (p.w_proj_a + z) : (i == 1 ? (p.w_proj_b + z) : (p.w_proj_c + z))) + (size_t)l * D * D; K = D; N = D; dst = (bf16_t*)(ws + WS_WP) + (size_t)i * D * D; }
        else if (t < 832) { tt = t - 768; src = (p.w_o + z) + (size_t)l * D * D; K = D; N = D; dst = (bf16_t*)(ws + WS_WO); }
        else if (t < 1088) { tt = t - 832; src = (p.w_ff1 + z) + (size_t)l * D * DFF; K = D; N = DFF; dst = (bf16_t*)(ws + WS_W1); }
        else if (t < 1344) { tt = t - 1088; src = (p.w_ff2 + z) + (size_t)l * D * DFF; K = DFF; N = D; dst = (bf16_t*)(ws + WS_W2); }
        else { const int g = (t - 1344) >> 2; tt = (t - 1344) & 3; src = (p.w_pool + z) + ((size_t)l * 4 + g) * 65536; K = 256; N = 256; dst = (bf16_t*)(ws + WS_WPOOL) + (size_t)g * 65536; }
        const int nkt = K / 64, kt = tt % nkt, ntile = tt / nkt;
        conv_tile(src, N, dst, K, kt * 64, ntile * 256, tile);
    }
    const float* wsp = (p.w_spatial + z) + (size_t)l * 4 * 128 * 128;
    bf16_t* bd = (bf16_t*)(ws + WS_WSBD);
    for (int i = blockIdx.x * 512 + opaque_tid(); i < 4 * 65536; i += gridDim.x * 512) {
        const int g = i >> 16, r = (i >> 8) & 255, c = i & 255;
        const bool on = ((r >> 7) == (c >> 7)) && ((c & 127) <= (r & 127));
        bd[i] = on ? f2bf(wsp[g * 16384 + (r & 127) * 128 + (c & 127)]) : (bf16_t)0;
    }
}

__device__ __forceinline__ void phase_xb(const Params& p, long z) {
    bf16_t* __restrict__ xb = (bf16_t*)((p.ws + z) + WS_SLOT0); const float* __restrict__ xp = p.x_prompt + z; const float* __restrict__ xs = p.x_sample + z;
    const int stride = gridDim.x * 512;
    for (int i0 = blockIdx.x * 512 + opaque_tid(); i0 < T * 128; i0 += 4 * stride) {
        float4 a[4], b[4];
#pragma unroll
        for (int j = 0; j < 4; ++j) { const int i = i0 + j * stride, row = i >> 7, c8 = (i & 127) * 8; a[j] = b[j] = make_float4(0.f, 0.f, 0.f, 0.f);
            if (row < TV) { const float* sp = (row < TP ? xp + (size_t)row * D : xs + (size_t)(row - TP) * D) + c8; a[j] = *(const float4*)sp; b[j] = *(const float4*)(sp + 4); } }
#pragma unroll
        for (int j = 0; j < 4; ++j) { const int i = i0 + j * stride, row = i >> 7, c8 = (i & 127) * 8;
            if (row < T) *(uint4*)(xb + (size_t)row * D + c8) = make_uint4(cvt_pk_bf16(a[j].x, a[j].y), cvt_pk_bf16(a[j].z, a[j].w), cvt_pk_bf16(b[j].x, b[j].y), cvt_pk_bf16(b[j].z, b[j].w)); }
    }
}

__device__ __forceinline__ void phase_e1(const Params& p, long z, int l, LAS unsigned char* lds, long wofs) {
    unsigned char* sl = (p.ws + z) + WS_SLOT0; const int tid = opaque_tid(), wid = tid >> 6, lane = tid & 63;
    const bf16_t* V = (const bf16_t*)(sl + 2 * SLOT); bf16_t* vnT = (bf16_t*)(sl + 6 * SLOT);
    LAS unsigned short* tile = (LAS unsigned short*)lds;
    const float* lg = (p.lnv_g + z) + l * D + lane * 16; const float* lb = (p.lnv_b + z) + l * D + lane * 16;
    for (int task = blockIdx.x; task < TV / 32; task += gridDim.x) {
        const int r0 = task * 32;
        uint4 va[4], vb[4];
#pragma unroll
        for (int rr = 0; rr < 4; ++rr) { const int row = r0 + wid * 4 + rr; va[rr] = *(const uint4*)(V + (size_t)row * D + lane * 16); vb[rr] = *(const uint4*)(V + (size_t)row * D + lane * 16 + 8); }
#pragma unroll
        for (int rr = 0; rr < 4; ++rr) {
            const int lr = wid * 4 + rr, row = r0 + lr;
            const uint4 a = va[rr], b = vb[rr];
            f32x4 x0, x1, x2, x3; unpack8(a, x0, x1); unpack8(b, x2, x3);
            float s = 0.f;
#pragma unroll
            for (int k = 0; k < 4; ++k) s += x0[k] + x1[k] + x2[k] + x3[k];
            const float mu = wave_sum(s) * (1.f / D);
            x0 -= mu; x1 -= mu; x2 -= mu; x3 -= mu;
            float q = 0.f;
#pragma unroll
            for (int k = 0; k < 4; ++k) q += x0[k] * x0[k] + x1[k] * x1[k] + x2[k] * x2[k] + x3[k] * x3[k];
            const float rs = rsqrtf(wave_sum(q) * (1.f / D) + LN_EPS);
            x0 = x0 * rs * *(const f32x4*)(lg) + *(const f32x4*)(lb); x1 = x1 * rs * *(const f32x4*)(lg + 4) + *(const f32x4*)(lb + 4);
            x2 = x2 * rs * *(const f32x4*)(lg + 8) + *(const f32x4*)(lb + 8); x3 = x3 * rs * *(const f32x4*)(lg + 12) + *(const f32x4*)(lb + 12);
            LAS unsigned* tw = (LAS unsigned*)(tile + lr * 1026 + lane * 16);
            const uint4 o0 = pack8(x0, x1), o1 = pack8(x2, x3);
            tw[0] = o0.x; tw[1] = o0.y; tw[2] = o0.z; tw[3] = o0.w; tw[4] = o1.x; tw[5] = o1.y; tw[6] = o1.z; tw[7] = o1.w;
            if (row >= TP && wofs == 0) { float* cv = (p.out + z) + O_CHV + ((size_t)l * TS + (row - TP)) * D + lane * 16;
                *(f32x4*)cv = x0; *(f32x4*)(cv + 4) = x1; *(f32x4*)(cv + 8) = x2; *(f32x4*)(cv + 12) = x3;
                const int g = lane >> 4; const float w00 = (p.w_spatial + z)[((size_t)l * 4 + g) * 16384], b0 = (p.b_spatial + z)[((size_t)l * 4 + g) * 128];
                bf16_t* up = (bf16_t*)(sl + 1 * SLOT) + (size_t)row * D + lane * 16; f32x4 u0, u1, u2, u3; unpack8(*(const uint4*)up, u0, u1); unpack8(*(const uint4*)(up + 8), u2, u3);
                *(uint4*)up = pack8(u0 * (x0 * w00 + b0), u1 * (x1 * w00 + b0)); *(uint4*)(up + 8) = pack8(u2 * (x2 * w00 + b0), u3 * (x3 * w00 + b0)); }
        }
        __syncthreads();
#pragma unroll 1
        for (int j = 0; j < 2; ++j) {
            const int c = tid + 512 * j; unsigned w[16];
#pragma unroll
            for (int t2 = 0; t2 < 16; ++t2) w[t2] = (unsigned)tile[(2 * t2) * 1026 + c] | ((unsigned)tile[(2 * t2 + 1) * 1026 + c] << 16);
            uint4* o = (uint4*)(vnT + (size_t)c * T + r0);
            o[0] = make_uint4(w[0], w[1], w[2], w[3]); o[1] = make_uint4(w[4], w[5], w[6], w[7]); o[2] = make_uint4(w[8], w[9], w[10], w[11]); o[3] = make_uint4(w[12], w[13], w[14], w[15]);
        }
        __syncthreads();
    }
    bf16_t* __restrict__ Bg = (bf16_t*)(sl + 3 * SLOT); const bf16_t* __restrict__ Z = (const bf16_t*)(sl + 4 * SLOT);
    const float* __restrict__ cw = (p.conv_w + z) + (size_t)l * 3 * D; const float* __restrict__ cb = (p.conv_b + z) + (size_t)l * D; const float* __restrict__ sc = (p.state_conv + z) + (size_t)l * TS * 2 * D;
    float* __restrict__ outp = p.out + z;
    for (int it = blockIdx.x * 512 + tid; it < (TV / 8) * 128; it += gridDim.x * 512) {
        const int c8 = (it & 127) * 8, r0 = (it >> 7) * 8;
        const f32x4 cb0 = *(const f32x4*)(cb + c8), cb1 = *(const f32x4*)(cb + c8 + 4), w00 = *(const f32x4*)(cw + c8), w01 = *(const f32x4*)(cw + c8 + 4),
                    w10 = *(const f32x4*)(cw + D + c8), w11 = *(const f32x4*)(cw + D + c8 + 4), w20 = *(const f32x4*)(cw + 2 * D + c8), w21 = *(const f32x4*)(cw + 2 * D + c8 + 4);
        uint4 bg[8], zz[8];
#pragma unroll
        for (int t = 0; t < 8; ++t) { bg[t] = *(const uint4*)(Bg + (size_t)(r0 + t) * D + c8); zz[t] = *(const uint4*)(Z + (size_t)(r0 + t) * D + c8); }
        if (r0 < TP) {
            const int pos0 = r0 & (SEQ - 1); uint4 zm1 = make_uint4(0, 0, 0, 0), zm2 = zm1;
            if (pos0 > 0) { zm1 = *(const uint4*)(Z + (size_t)(r0 - 1) * D + c8); zm2 = *(const uint4*)(Z + (size_t)(r0 - 2) * D + c8); }
            f32x4 p10, p11, p20, p21; unpack8(zm1, p10, p11); unpack8(zm2, p20, p21);
#pragma unroll
            for (int t = 0; t < 8; ++t) { f32x4 z0, z1, b0, b1; unpack8(zz[t], z0, z1); unpack8(bg[t], b0, b1);
                const f32x4 y0 = cb0 + w00 * p20 + w10 * p10 + w20 * z0, y1 = cb1 + w01 * p21 + w11 * p11 + w21 * z1;
                *(uint4*)((char*)(Bg + (size_t)(r0 + t) * D + c8) + wofs) = pack8(b0 * y0, b1 * y1);
                if (pos0 + t >= SEQ - 2) { float* o = outp + O_CONVP + (((size_t)l * 8 + (r0 >> 11)) * 2 + (pos0 + t - (SEQ - 2))) * D + c8; *(f32x4*)o = z0; *(f32x4*)(o + 4) = z1; }
                p20 = p10; p21 = p11; p10 = z0; p11 = z1; }
        } else {
#pragma unroll
            for (int t = 0; t < 8; ++t) { const int bi = r0 + t - TP; const float* s0 = sc + (size_t)bi * 2 * D + c8; f32x4 z0, z1, b0, b1; unpack8(zz[t], z0, z1); unpack8(bg[t], b0, b1);
                const f32x4 p20 = *(const f32x4*)s0, p21 = *(const f32x4*)(s0 + 4), p10 = *(const f32x4*)(s0 + D), p11 = *(const f32x4*)(s0 + D + 4);
                float* o = outp + O_CONVS + ((size_t)l * TS + bi) * 2 * D + c8; *(f32x4*)o = p10; *(f32x4*)(o + 4) = p11; *(f32x4*)(o + D) = z0; *(f32x4*)(o + D + 4) = z1;
                const f32x4 y0 = cb0 + w00 * p20 + w10 * p10 + w20 * z0, y1 = cb1 + w01 * p21 + w11 * p11 + w21 * z1;
                *(uint4*)((char*)(Bg + (size_t)(r0 + t) * D + c8) + wofs) = pack8(b0 * y0, b1 * y1); }
        }
    }
}

template <int W>
__device__ __forceinline__ void e2_block(const bf16_t* __restrict__ XC, bf16_t* __restrict__ Dd, float* __restrict__ outp, int l, int r0, int c8) {
    const int pos0 = r0 & (SEQ - 1);
    uint4 x[15 + W];
#pragma unroll
    for (int k = 0; k < 15 + W; ++k) { const int rr = r0 - (W - 1) + k; x[k] = make_uint4(0, 0, 0, 0); if (k >= W - 1 || pos0 > 0) x[k] = *(const uint4*)(XC + (size_t)rr * D + c8); }
    f32x4 s0 = (f32x4){0.f, 0.f, 0.f, 0.f}, s1 = s0;
#pragma unroll
    for (int k = 0; k < W - 1; ++k) { f32x4 a, b; unpack8(x[k], a, b); s0 += a; s1 += b; }
#pragma unroll
    for (int t = 0; t < 16; ++t) {
        f32x4 a, b; unpack8(x[W - 1 + t], a, b); s0 += a; s1 += b;
        const int pos = pos0 + t; const float inv = 1.f / (float)(pos + 1 < W ? pos + 1 : W);
        *(uint4*)(Dd + (size_t)(r0 + t) * D + c8) = pack8(s0 * inv - a, s1 * inv - b);
        if (pos >= SEQ - 15) { float* o = outp + O_POOLP + (((size_t)l * 8 + (r0 >> 11)) * 15 + (pos - (SEQ - 15))) * D + c8; *(f32x4*)o = a; *(f32x4*)(o + 4) = b; }
        f32x4 e, f; unpack8(x[t], e, f); s0 -= e; s1 -= f;
    }
}
__device__ __forceinline__ void phase_e2(const Params& p, long z, int l) {
    unsigned char* sl = (p.ws + z) + WS_SLOT0; const bf16_t* __restrict__ XC = (const bf16_t*)(sl + 5 * SLOT); bf16_t* __restrict__ Dd = (bf16_t*)(sl + 2 * SLOT);
    const float* __restrict__ sp = (p.state_pool + z) + (size_t)l * TS * 15 * D; float* __restrict__ outp = p.out + z;
    const f32x4 zero = (f32x4){0.f, 0.f, 0.f, 0.f};
    for (int i = blockIdx.x * 512 + opaque_tid(); i < (TV / 16) * 128; i += gridDim.x * 512) {
        const int g = (i >> 6) & 3, c8 = g * 256 + (i & 31) * 8, r0 = (((i >> 8) << 1) | ((i >> 5) & 1)) * 16, w = 2 << g;
        if (r0 < TP) {
            if (g == 0) e2_block<2>(XC, Dd, outp, l, r0, c8); else if (g == 1) e2_block<4>(XC, Dd, outp, l, r0, c8); else if (g == 2) e2_block<8>(XC, Dd, outp, l, r0, c8); else e2_block<16>(XC, Dd, outp, l, r0, c8);
        } else {
#pragma unroll 1
            for (int t = 0; t < 16; ++t) {
                const int row = r0 + t, bi = row - TP; f32x4 a, b; unpack8(*(const uint4*)(XC + (size_t)row * D + c8), a, b);
                const float* sb = sp + (size_t)bi * 15 * D + c8; f32x4 s0 = a, s1 = b;
                float* o = outp + O_POOLS + ((size_t)l * TS + bi) * 15 * D + c8;
#pragma unroll
                for (int j = 14; j >= 0; --j) { const f32x4 e = *(const f32x4*)(sb + (size_t)j * D), f = *(const f32x4*)(sb + (size_t)j * D + 4);
                    if (15 - j < w) { s0 += e; s1 += f; }
                    if (j >= 1) { *(f32x4*)(o + (size_t)(j - 1) * D) = e; *(f32x4*)(o + (size_t)(j - 1) * D + 4) = f; } }
                *(f32x4*)(o + 14 * D) = a; *(f32x4*)(o + 14 * D + 4) = b;
                const float inv = 1.f / (float)w;
                *(uint4*)(Dd + (size_t)row * D + c8) = pack8(s0 * inv - a, s1 * inv - b);
            }
        }
    }
}

__device__ __forceinline__ void phase_ln(const float* __restrict__ Y, const float* __restrict__ g, const float* __restrict__ b, bf16_t* __restrict__ ob, float* __restrict__ stats, float* __restrict__ of) {
    const int tid = opaque_tid(), lane = tid & 63, gw = blockIdx.x * 8 + (tid >> 6), nw = gridDim.x * 8;
    f32x4 gv[4], bv[4];
#pragma unroll
    for (int j = 0; j < 4; ++j) { gv[j] = *(const f32x4*)(g + j * 256 + lane * 4); bv[j] = *(const f32x4*)(b + j * 256 + lane * 4); }
    for (int row0 = gw; row0 < TV; row0 += 2 * nw) {
        f32x4 x[2][4];
#pragma unroll
        for (int r = 0; r < 2; ++r) { const int row = row0 + r * nw;
#pragma unroll
            for (int j = 0; j < 4; ++j) { x[r][j] = (f32x4){0.f, 0.f, 0.f, 0.f}; if (row < TV) x[r][j] = *(const f32x4*)(Y + (size_t)row * D + j * 256 + lane * 4); } }
#pragma unroll
        for (int r = 0; r < 2; ++r) { const int row = row0 + r * nw; if (row >= TV) break;
            float s = 0.f;
#pragma unroll
            for (int j = 0; j < 4; ++j) s += x[r][j][0] + x[r][j][1] + x[r][j][2] + x[r][j][3];
            const float mu = wave_sum(s) * (1.f / D); float q = 0.f;
#pragma unroll
            for (int j = 0; j < 4; ++j) { x[r][j] -= mu; q += x[r][j][0] * x[r][j][0] + x[r][j][1] * x[r][j][1] + x[r][j][2] * x[r][j][2] + x[r][j][3] * x[r][j][3]; }
            const float rs = rsqrtf(wave_sum(q) * (1.f / D) + LN_EPS);
            if (stats && lane == 0) { stats[2 * row] = mu; stats[2 * row + 1] = rs; }
#pragma unroll
            for (int j = 0; j < 4; ++j) { const f32x4 y = x[r][j] * rs * gv[j] + bv[j];
                *(uint2*)(ob + (size_t)row * D + j * 256 + lane * 4) = make_uint2(cvt_pk_bf16(y[0], y[1]), cvt_pk_bf16(y[2], y[3]));
                if (of) *(f32x4*)(of + (size_t)row * D + j * 256 + lane * 4) = y; }
        }
    }
}

__device__ __forceinline__ float2 sk_tile(LAS float* red, const bf16_t* A, int lda, const bf16_t* Bt, int ldb, int K, int tid) {
    const int wid = tid >> 6, lane = tid & 63, fr = lane & 15, fq = lane >> 4, kw = K >> 3, kq = kw >> 2;
    const bf16_t* a0 = A + (size_t)fr * lda + wid * kw + fq * kq; const bf16_t* a1 = a0 + (size_t)16 * lda;
    const bf16_t* b0 = Bt + (size_t)fr * ldb + wid * kw + fq * kq; const bf16_t* b1 = b0 + (size_t)16 * ldb;
    f32x4 c00 = (f32x4){0.f, 0.f, 0.f, 0.f}, c01 = c00, c10 = c00, c11 = c00;
#pragma unroll 4
    for (int s = 0; s < kq; s += 8) {
        const bf16x8 av0 = *(const bf16x8*)(a0 + s), av1 = *(const bf16x8*)(a1 + s), bv0 = *(const bf16x8*)(b0 + s), bv1 = *(const bf16x8*)(b1 + s);
        c00 = __builtin_amdgcn_mfma_f32_16x16x32_bf16(bv0, av0, c00, 0, 0, 0); c01 = __builtin_amdgcn_mfma_f32_16x16x32_bf16(bv1, av0, c01, 0, 0, 0);
        c10 = __builtin_amdgcn_mfma_f32_16x16x32_bf16(bv0, av1, c10, 0, 0, 0); c11 = __builtin_amdgcn_mfma_f32_16x16x32_bf16(bv1, av1, c11, 0, 0, 0);
    }
    LAS float* w = red + wid * 1024 + fr * 32 + fq * 4;
    *(LAS f32x4*)(w) = c00; *(LAS f32x4*)(w + 16) = c01; *(LAS f32x4*)(w + 512) = c10; *(LAS f32x4*)(w + 528) = c11;
    __syncthreads();
    float2 r = make_float2(0.f, 0.f);
#pragma unroll
    for (int k = 0; k < 8; ++k) { const f32x2 v = *(const LAS f32x2*)(red + k * 1024 + tid * 2); r.x += v[0]; r.y += v[1]; }
    __syncthreads();
    return r;
}
#define SK_ROWCOL const int srow = tid >> 4, scol = (tid & 15) * 2

__device__ __forceinline__ void sphase_g1(unsigned char* ws, LAS float* red) {
    const int tid = opaque_tid(); SK_ROWCOL; unsigned char* sl = ws + WS_SLOT0; const bf16_t* win = (const bf16_t*)(ws + WS_WIN);
    for (int task = blockIdx.x; task < 640; task += gridDim.x) {
        const int seg = task >> 7, ct = (task & 127) >> 2, rt = task & 3;
        const bf16_t* A = (const bf16_t*)sl + (size_t)(TP + rt * 32) * D;
        float2 v; int so;
        if (seg != 3) { v = sk_tile(red, A, D, win + (size_t)((seg < 3 ? seg * 1024 : 5120) + ct * 32) * D, D, D, tid); so = seg < 3 ? 1 + seg : 5; }
        else { const float2 c = sk_tile(red, A, D, win + (size_t)(3072 + ct * 32) * D, D, D, tid), x = sk_tile(red, A, D, win + (size_t)(4096 + ct * 32) * D, D, D, tid); v = make_float2(c.x * x.x, c.y * x.y); so = 4; }
        *(unsigned*)((bf16_t*)(sl + (size_t)so * SLOT) + (size_t)(TP + rt * 32 + srow) * D + ct * 32 + scol) = cvt_pk_bf16(v.x, v.y);
    }
}
__device__ __forceinline__ void sphase_pool(unsigned char* ws, const float* pscale, LAS float* red) {
    const int tid = opaque_tid(); SK_ROWCOL; unsigned char* sl = ws + WS_SLOT0;
    for (int task = blockIdx.x; task < 128; task += gridDim.x) {
        const int g = task >> 5, ct = (task & 31) >> 2, rt = task & 3;
        const float2 v = sk_tile(red, (const bf16_t*)(sl + 2 * SLOT) + (size_t)(TP + rt * 32) * D + g * 256, D, (const bf16_t*)(ws + WS_WPOOL) + (size_t)g * 65536 + (size_t)ct * 32 * 256, 256, 256, tid);
        const int c = g * 256 + ct * 32 + scol;
        *(unsigned*)((bf16_t*)(ws + WS_SHC) + (size_t)(rt * 32 + srow) * D + c) = cvt_pk_bf16(v.x * pscale[c], v.y * pscale[c + 1]);
    }
}
__device__ __forceinline__ void sphase_gg(unsigned char* ws, LAS float* red) {
    const int tid = opaque_tid(); SK_ROWCOL; unsigned char* sl = ws + WS_SLOT0; const bf16_t* win = (const bf16_t*)(ws + WS_WIN);
    for (int task = blockIdx.x; task < 384; task += gridDim.x) {
        const int gi = task >> 7, ct = (task & 127) >> 2, rt = task & 3;
        const float2 v = sk_tile(red, (const bf16_t*)sl + (size_t)(TP + rt * 32) * D, D, win + (size_t)(6144 + gi * 1024 + ct * 32) * D, D, D, tid);
        *(unsigned*)((bf16_t*)(sl + (size_t)(4 + gi) * SLOT) + (size_t)(TP + rt * 32 + srow) * D + ct * 32 + scol) = cvt_pk_bf16(1.f / (1.f + __expf(-v.x)), 1.f / (1.f + __expf(-v.y)));
    }
}
__device__ __forceinline__ void sphase_p3(unsigned char* ws, LAS float* red) {
    const int tid = opaque_tid(); SK_ROWCOL; unsigned char* sl = ws + WS_SLOT0; const bf16_t* wp = (const bf16_t*)(ws + WS_WP);
    for (int task = blockIdx.x; task < 128; task += gridDim.x) {
        const int ct = task >> 2, rt = task & 3; float2 tot = make_float2(0.f, 0.f);
#pragma unroll 1
        for (int i = 0; i < 3; ++i) {
            const bf16_t* A = i == 0 ? (const bf16_t*)(sl + 1 * SLOT) + (size_t)(TP + rt * 32) * D : (i == 1 ? (const bf16_t*)(sl + 3 * SLOT) + (size_t)(TP + rt * 32) * D : (const bf16_t*)(ws + WS_SHC) + (size_t)(rt * 32) * D);
            const float2 v = sk_tile(red, A, D, wp + (size_t)(i * 1024 + ct * 32) * D, D, D, tid);
            const unsigned gg = *(const unsigned*)((const bf16_t*)(sl + (size_t)(4 + i) * SLOT) + (size_t)(TP + rt * 32 + srow) * D + ct * 32 + scol);
            tot.x += bflo(gg) * v.x; tot.y += bfhi(gg) * v.y;
        }
        *(unsigned*)((bf16_t*)sl + (size_t)(TP + rt * 32 + srow) * D + ct * 32 + scol) = cvt_pk_bf16(tot.x, tot.y);
    }
}
__device__ __forceinline__ void sphase_wo(unsigned char* ws, const float* xs, LAS float* red) {
    const int tid = opaque_tid(); SK_ROWCOL; unsigned char* sl = ws + WS_SLOT0;
    for (int task = blockIdx.x; task < 128; task += gridDim.x) {
        const int ct = task >> 2, rt = task & 3;
        const float2 v = sk_tile(red, (const bf16_t*)sl + (size_t)(TP + rt * 32) * D, D, (const bf16_t*)(ws + WS_WO) + (size_t)ct * 32 * D, D, D, tid);
        const int c = ct * 32 + scol; const float2 xv = *(const float2*)(xs + (size_t)(rt * 32 + srow) * D + c);
        *(float2*)((float*)(sl + 4 * SLOT) + (size_t)(TP + rt * 32 + srow) * D + c) = make_float2(ALPHA * xv.x + v.x, ALPHA * xv.y + v.y);
    }
}
__device__ __forceinline__ void sphase_ff1(unsigned char* ws, LAS float* red) {
    const int tid = opaque_tid(); SK_ROWCOL; unsigned char* sl = ws + WS_SLOT0;
    for (int task = blockIdx.x; task < 512; task += gridDim.x) {
        const int ct = task >> 2, rt = task & 3;
        const float2 v = sk_tile(red, (const bf16_t*)(sl + 6 * SLOT) + (size_t)(TP + rt * 32) * D, D, (const bf16_t*)(ws + WS_W1) + (size_t)ct * 32 * D, D, D, tid);
        const float a = fmaxf(v.x, 0.f), b = fmaxf(v.y, 0.f);
        *(unsigned*)((bf16_t*)sl + (size_t)(TP + rt * 32 + srow) * DFF + ct * 32 + scol) = cvt_pk_bf16(a * a, b * b);
    }
}
__device__ __forceinline__ void sphase_ff2(unsigned char* ws, const float* g, const float* b, LAS float* red) {
    const int tid = opaque_tid(); SK_ROWCOL; unsigned char* sl = ws + WS_SLOT0; const float* stats = (const float*)(ws + WS_STATS);
    for (int task = blockIdx.x; task < 128; task += gridDim.x) {
        const int ct = task >> 2, rt = task & 3;
        const float2 v = sk_tile(red, (const bf16_t*)sl + (size_t)(TP + rt * 32) * DFF, DFF, (const bf16_t*)(ws + WS_W2) + (size_t)ct * 32 * DFF, DFF, DFF, tid);
        const int row = TP + rt * 32 + srow, c = ct * 32 + scol; const float mu = stats[2 * row], rs = stats[2 * row + 1];
        float2* q = (float2*)((float*)(sl + 4 * SLOT) + (size_t)row * D + c); const float2 y = *q;
        *q = make_float2(ALPHA * ((y.x - mu) * rs * g[c] + b[c]) + v.x, ALPHA * ((y.y - mu) * rs * g[c + 1] + b[c + 1]) + v.y);
    }
}


#define XB_TMO      128
#define XB_XCNT(j)  (256  + 64 * (j))
#define XB_XSUB(j)  (1280 + 64 * (j))
#define XB_XGEN(j)  (2304 + 64 * (j))
#define XB_TOP      3328
#define XB_TOPGEN   3392
#define XCD_BAR_WORDS 3456
#define XB_SPIN_CAP (1u << 18)
__device__ __forceinline__ unsigned xb_ld(unsigned* p)              { return __hip_atomic_load(p, __ATOMIC_RELAXED, __HIP_MEMORY_SCOPE_AGENT); }
__device__ __forceinline__ unsigned xb_add(unsigned* p, unsigned v) { return __hip_atomic_fetch_add(p, v, __ATOMIC_RELAXED, __HIP_MEMORY_SCOPE_AGENT); }
__device__ __forceinline__ unsigned xb_xcc_id() { return (unsigned)__builtin_amdgcn_s_getreg((3 << 11) | 20) & 0xFu; }
#define XB_SPIN(cond, bar) do { unsigned _sp = 0; while (cond) { __builtin_amdgcn_s_sleep(1); \
    if ((++_sp & 255u) == 0u) { if (xb_ld(&(bar)[XB_TMO])) break; if (_sp > XB_SPIN_CAP) { atomicAdd(&(bar)[XB_TMO], 1u); break; } } } } while (0)
struct XcdBarrier { unsigned* bar; unsigned x; volatile LAS unsigned* st; };
__device__ __forceinline__ XcdBarrier xcd_barrier_post(unsigned* bar, volatile LAS unsigned* st) {
    XcdBarrier b; b.bar = bar; b.x = xb_xcc_id(); b.st = st;
    if (threadIdx.x == 0) (void)xb_add(&bar[XB_XCNT(b.x)], 1u);
    return b;
}
__device__ __forceinline__ void xcd_barrier_complete(unsigned* bar, unsigned x, unsigned& nloc, unsigned& nx) {
    const unsigned G = gridDim.x * gridDim.y * gridDim.z;
    unsigned sum, cnt, mine, sp = 0u;
    for (;;) {
        sum = 0u; cnt = 0u; mine = 0u;
#pragma unroll
        for (unsigned j = 0; j < 16; ++j) { const unsigned c = xb_ld(&bar[XB_XCNT(j)]); sum += c; cnt += (c > 0u) ? 1u : 0u; mine = (j == x) ? c : mine; }
        if (sum == G) break;
        __builtin_amdgcn_s_sleep(1);
        if ((++sp & 255u) == 0u) { if (xb_ld(&bar[XB_TMO])) break; if (sp > XB_SPIN_CAP) { atomicAdd(&bar[XB_TMO], 1u); break; } }
    }
    nloc = mine > 0u ? mine : 1u; nx = cnt > 0u ? cnt : 1u;
}
__device__ __forceinline__ void xcd_barrier(const XcdBarrier& b) {
    asm volatile("s_waitcnt vmcnt(0)" ::: "memory");
    __syncthreads();
    if (threadIdx.x == 0) {
        unsigned* bar = b.bar;
        __builtin_amdgcn_s_waitcnt(0);
        unsigned nloc = b.st[0], nx = b.st[1];
        if (nloc == 0u) { xcd_barrier_complete(bar, b.x, nloc, nx); b.st[0] = nloc; b.st[1] = nx; }
        const unsigned old = xb_add(&bar[XB_XSUB(b.x)], 1u);
        const unsigned gen = old / nloc;
        if (old + 1u == (gen + 1u) * nloc) {
            __builtin_amdgcn_fence(__ATOMIC_RELEASE, "agent");
            asm volatile("s_waitcnt vmcnt(0)" ::: "memory");
            const unsigned og = xb_add(&bar[XB_TOP], 1u);
            const unsigned tg = og / nx;
            if (og + 1u == (tg + 1u) * nx) xb_add(&bar[XB_TOPGEN], 1u);
            else XB_SPIN(xb_ld(&bar[XB_TOPGEN]) == tg, bar);
            __builtin_amdgcn_fence(__ATOMIC_ACQUIRE, "agent");
            xb_add(&bar[XB_XGEN(b.x)], 1u);
            asm volatile("s_waitcnt vmcnt(0)" ::: "memory");
        } else {
            XB_SPIN(xb_ld(&bar[XB_XGEN(b.x)]) == gen, bar);
            __builtin_amdgcn_fence(__ATOMIC_ACQUIRE, "agent");
            asm volatile("s_waitcnt vmcnt(0)" ::: "memory");
        }
    }
    __syncthreads();
}

__global__ void __launch_bounds__(512, 2) mega(Params p) {
    extern __shared__ __attribute__((aligned(16))) unsigned char shm[];
    LAS unsigned char* lds = (LAS unsigned char*)shm;
    cg::grid_group grid = cg::this_grid();
    volatile LAS unsigned* xst = (volatile LAS unsigned*)(lds + STAGE_BYTES);
    if (threadIdx.x == 0) { xst[0] = 0u; xst[1] = 0u; }
    __syncthreads();
    const XcdBarrier xb = xcd_barrier_post((unsigned*)(p.ws + WS_BAR), xst);
    for (int ph = p.ph0; ph < p.ph1; ++ph) {
        long z = 0; asm volatile("" : "+s"(z));
        unsigned char* ws = p.ws + z; unsigned char* sl = ws + WS_SLOT0;
#ifndef REP_MASK
#define REP_MASK 0
#endif
#ifndef EXTRA_SYNC
#define EXTRA_SYNC 0
#endif
#ifndef DRY_MASK
#define DRY_MASK 0
#endif
        const int kk = ph == 0 ? 11 : (ph - 1) % 11;
        const int nrep = (((REP_MASK >> kk) & 1) || (((DRY_MASK >> kk) & 1) && ph <= 11)) ? 2 : 1;
        for (int rep = 0; rep < nrep; ++rep)
        if (ph == 0) { phase_convert(p, z, 0, lds); phase_xb(p, z); }
        else {
            const int l = (ph - 1) / 11, k = (ph - 1) % 11;
            switch (k) {
            case 0: { SchedG1 S{(const char*)sl, (const char*)(ws + WS_WIN)}; EpiG1 E{sl}; gemm_phase(lds, S, E); } sphase_g1(ws, (LAS float*)lds); break;
            case 1: { const long wofs = (((DRY_MASK >> 1) & 1) && l == 0 && rep == 0) ? (long)((unsigned char*)(p.out + z) - (sl + 3 * SLOT)) : 0; phase_e1(p, z, l, lds, wofs); } break;
            case 2: phase_e2(p, z, l); break;
            case 3: { { SchedPool S{(const char*)(sl + 2 * SLOT), (const char*)(ws + WS_WPOOL)}; EpiPool E{sl, (p.pool_scale + z) + (size_t)l * D, (((DRY_MASK >> 3) & 1) && l == 0 && rep == 0) ? (long)((unsigned char*)(p.out + z) - (sl + 2 * SLOT)) : 0}; gemm_phase(lds, S, E); }
                      { SchedSpat S{(const char*)(ws + WS_WSBD), (const char*)(sl + 6 * SLOT)}; EpiSpat E{sl, (p.b_spatial + z) + (size_t)l * 4 * 128, (((DRY_MASK >> 3) & 1) && l == 0 && rep == 0) ? (long)((unsigned char*)(p.out + z) + (size_t)TP * D * 2 - (sl + 1 * SLOT)) : 0}; gemm_phase(lds, S, E); } } sphase_pool(ws, (p.pool_scale + z) + (size_t)l * D, (LAS float*)lds); break;
            case 4: { SchedGG S{(const char*)sl, (const char*)(ws + WS_WIN)}; EpiGG E{sl}; gemm_phase(lds, S, E); } sphase_gg(ws, (LAS float*)lds); break;
            case 5: { SchedP3 S{(const char*)sl, (const char*)(ws + WS_WP)}; EpiP3 E{sl}; gemm_phase(lds, S, E); } sphase_p3(ws, (LAS float*)lds); break;
            case 6: { SchedN4 S{(const char*)sl, (const char*)(ws + WS_WO)};
                      EpiWO E{(float*)(sl + 4 * SLOT), l == 0 ? (p.x_prompt + z) : (p.out + z)}; gemm_phase(lds, S, E); } sphase_wo(ws, l == 0 ? (p.x_sample + z) : (p.out + z) + (size_t)TP * D, (LAS float*)lds); break;
            case 7: phase_ln((const float*)(sl + 4 * SLOT), (p.ln1_g + z) + l * D, (p.ln1_b + z) + l * D, (bf16_t*)(sl + 6 * SLOT), (float*)(ws + WS_STATS), nullptr); break;
            case 8: { SchedFF1 S{(const char*)(sl + 6 * SLOT), (const char*)(ws + WS_W1)}; EpiFF1 E{(bf16_t*)sl}; gemm_phase(lds, S, E); } sphase_ff1(ws, (LAS float*)lds); break;
            case 9: { SchedFF2 S{(const char*)sl, (const char*)(ws + WS_W2)};
                      EpiFF2 E{(float*)(sl + 4 * SLOT), (const float*)(ws + WS_STATS), (p.ln1_g + z) + l * D, (p.ln1_b + z) + l * D, (((DRY_MASK >> 9) & 1) && l == 0 && rep == 0) ? (long)((unsigned char*)(p.out + z) - (sl + 4 * SLOT)) : 0}; gemm_phase(lds, S, E); } if (!((((DRY_MASK >> 9) & 1) && l == 0 && rep == 0))) sphase_ff2(ws, (p.ln1_g + z) + l * D, (p.ln1_b + z) + l * D, (LAS float*)lds); break;
            case 10: phase_ln((const float*)(sl + 4 * SLOT), (p.ln2_g + z) + l * D, (p.ln2_b + z) + l * D, (bf16_t*)sl, nullptr, (p.out + z));
                     if (l == 0) phase_convert(p, z, 1, lds); break;
            }
        }
        if (ph + 1 < p.ph1) { if (ph == 0) grid.sync(); else xcd_barrier(xb); for (int e = 0; e < EXTRA_SYNC; ++e) xcd_barrier(xb); }
    }
}

extern "C" void kernel_launch(void* const* d_in, const int* in_sizes, int n_in, void* d_out, int out_size, void* d_ws, size_t ws_size, hipStream_t stream) {
    static int grid = 0;
    if (grid == 0) {
        if (n_in != 23 || ws_size < WS_END) { fprintf(stderr, "kernel_launch: need 23 inputs and >= %zu bytes of workspace; got %d, %zu\n", (size_t)WS_END, n_in, ws_size); grid = -1; return; }
        int dev = 0, cus = 0, per_cu = 0;
        hipGetDevice(&dev); hipDeviceGetAttribute(&cus, hipDeviceAttributeMultiprocessorCount, dev);
        if (hipFuncSetAttribute((const void*)mega, hipFuncAttributeMaxDynamicSharedMemorySize, LDS_BYTES) != hipSuccess) { fprintf(stderr, "kernel_launch: hipFuncSetAttribute failed\n"); grid = -1; return; }
        if (hipOccupancyMaxActiveBlocksPerMultiprocessor(&per_cu, (const void*)mega, 512, LDS_BYTES) != hipSuccess || per_cu < 1) { fprintf(stderr, "kernel_launch: occupancy query failed (%d)\n", per_cu); grid = -1; return; }
        grid = cus;
    }
    if (grid < 0) return;
    Params p{};
    const float** pp = (const float**)&p;
    for (int i = 0; i < 23; ++i) pp[i] = (const float*)d_in[i];
    p.out = (float*)d_out; p.ws = (unsigned char*)d_ws; p.ph0 = 0; p.ph1 = 23;
    if (hipMemsetAsync((char*)d_ws + WS_BAR, 0, 16384, stream) != hipSuccess) { fprintf(stderr, "kernel_launch: memset of barrier words failed\n"); return; }
    void* args[] = {&p};
    hipError_t e = hipLaunchCooperativeKernel((const void*)mega, dim3(grid), dim3(512), args, LDS_BYTES, stream);
    if (e != hipSuccess) fprintf(stderr, "cooperative launch failed: %s (grid %d)\n", hipGetErrorString(e), grid);
}
```
